# Optimizing an MI355X kernel written in HIP

```python
import jax, jax.numpy as jnp
from jax import lax
import numpy as np

D_MODEL = 1024
BATCH = 16
SEQ = 2048
DEPTH = 1

HEAD_DIM = 64
N_HEADS = D_MODEL // HEAD_DIM
N_HEADS_NSA = N_HEADS // 2
N_KV_NSA = 2
N_HEADS_SWA = N_HEADS - N_HEADS_NSA
N_KV_SWA = 2
MIX_WIDTH = N_HEADS * HEAD_DIM
CMP_BLOCK = 32
CMP_STRIDE = 16
CMP_HIDDEN = 4 * HEAD_DIM
SEL_BLOCK = 64
SEL_TOPN = 8
NSA_WINDOW = 512
SWA_WINDOW = 128
Q_BLOCK = 128
D_FF = 4 * D_MODEL
NORM_EPS = 1e-6
N_NSA_BRANCHES = 3

kernel_name = "hymba_nsa_swa_sink_alibi_sandwich_block"


def rms_norm(x, g):
    xf = x.astype(jnp.float32)
    y = xf * lax.rsqrt(jnp.mean(xf * xf, axis=-1, keepdims=True) + NORM_EPS)
    return (y * g.astype(jnp.float32)).astype(x.dtype)


def alibi_slopes():
    s = 2.0 ** (-8.0 * (np.arange(N_HEADS) + 1) / N_HEADS)
    s = jnp.asarray(s, dtype=jnp.float32)
    nsa = s[0::2].reshape(N_KV_NSA, N_HEADS_NSA // N_KV_NSA)
    swa = s[1::2].reshape(N_KV_SWA, N_HEADS_SWA // N_KV_SWA)
    return nsa, swa


def masked_softmax(s, mask, sink=None):
    s = jnp.where(mask, s, -jnp.inf)
    m = jnp.max(s, axis=-1, keepdims=True)
    if sink is not None:
        m = jnp.maximum(m, sink)
    m = jnp.where(jnp.isfinite(m), m, 0.0)
    e = jnp.exp(s - m)
    denom = jnp.sum(e, axis=-1, keepdims=True)
    if sink is not None:
        denom = denom + jnp.exp(sink - m)
    return e / jnp.where(denom > 0, denom, 1.0)


def compress_blocks(kv, pe, w1, w2):
    B, G, T, D = kv.shape
    n_cmp = (T - CMP_BLOCK) // CMP_STRIDE + 1
    idx = np.arange(n_cmp)[:, None] * CMP_STRIDE + np.arange(CMP_BLOCK)[None, :]
    blocks = kv[:, :, idx, :] + pe
    flat = blocks.reshape(B, G, n_cmp, CMP_BLOCK * D)
    return jax.nn.gelu(flat @ w1) @ w2


def banded_attention(q, k, v, slopes, window, sinks=None):
    B, G, R, T, D = q.shape
    scale = D ** -0.5
    n_blk = T // Q_BLOCK
    L = window + Q_BLOCK
    kp = jnp.pad(k, ((0, 0), (0, 0), (window, 0), (0, 0)))
    vp = jnp.pad(v, ((0, 0), (0, 0), (window, 0), (0, 0)))
    sink = None if sinks is None else sinks.astype(jnp.float32)[None, :, :, None, None]

    def body(c):
        start = c * Q_BLOCK
        q_b = lax.dynamic_slice_in_dim(q, start, Q_BLOCK, axis=3)
        ks = lax.dynamic_slice_in_dim(kp, start, L, axis=2)
        vs = lax.dynamic_slice_in_dim(vp, start, L, axis=2)
        pos_q = start + jnp.arange(Q_BLOCK)
        pos_k = start - window + jnp.arange(L)
        dist = pos_q[:, None] - pos_k[None, :]
        mask = (pos_k >= 0)[None, :] & (dist >= 0) & (dist < window)
        s = jnp.einsum('bgrqd,bgkd->bgrqk', q_b, ks).astype(jnp.float32) * scale
        s = s - slopes[None, :, :, None, None] * dist.astype(jnp.float32)
        p = masked_softmax(s, mask, sink)
        return jnp.einsum('bgrqk,bgkd->bgrqd', p.astype(vs.dtype), vs)

    out = lax.map(body, jnp.arange(n_blk))
    return out.transpose(1, 2, 3, 0, 4, 5).reshape(B, G, R, T, D)


def selected_attention(q, k, v, tok, slopes):
    B, G, R, T, D = q.shape
    scale = D ** -0.5
    n_blk = T // Q_BLOCK
    qc = q.reshape(B, G, R, n_blk, Q_BLOCK, D).transpose(3, 0, 1, 2, 4, 5)
    tc = tok.reshape(B, G, n_blk, Q_BLOCK, -1).transpose(2, 0, 1, 3, 4)
    pc = jnp.arange(T).reshape(n_blk, Q_BLOCK)
    gather = jax.vmap(jax.vmap(lambda kk, ii: kk[ii]))

    def body(args):
        q_b, tok_b, pos_b = args
        ks = gather(k, tok_b)
        vs = gather(v, tok_b)
        dist = pos_b[None, None, :, None] - tok_b
        s = jnp.einsum('bgrqd,bgqkd->bgrqk', q_b, ks).astype(jnp.float32) * scale
        s = s - slopes[None, :, :, None, None] * dist[:, :, None].astype(jnp.float32)
        p = masked_softmax(s, (dist >= 0)[:, :, None])
        return jnp.einsum('bgrqk,bgqkd->bgrqd', p.astype(vs.dtype), vs)

    out = lax.map(body, (qc, tc, pc))
    return out.transpose(1, 2, 3, 0, 4, 5).reshape(B, G, R, T, D)


def nsa_attention(q, k_cmp, v_cmp, k_slc, v_slc, k_win, v_win, gates, slopes,
                  pe_k, w1_k, w2_k, pe_v, w1_v, w2_v):
    B, G, R, T, D = q.shape
    scale = D ** -0.5
    pos = jnp.arange(T)
    kc = compress_blocks(k_cmp, pe_k, w1_k, w2_k)
    vc = compress_blocks(v_cmp, pe_v, w1_v, w2_v)
    n_cmp = kc.shape[2]
    cmp_start = jnp.arange(n_cmp) * CMP_STRIDE
    cmp_end = cmp_start + CMP_BLOCK - 1
    dist_c = pos[:, None] - cmp_end[None, :]
    s = jnp.einsum('bgrtd,bgnd->bgrtn', q, kc).astype(jnp.float32) * scale
    s = s - slopes[None, :, :, None, None] * dist_c.astype(jnp.float32)
    p_cmp = masked_softmax(s, dist_c >= 0)
    o_cmp = jnp.einsum('bgrtn,bgnd->bgrtd', p_cmp.astype(vc.dtype), vc)
    n_sel = T // SEL_BLOCK
    sel_start = jnp.arange(n_sel) * SEL_BLOCK
    overlap = ((cmp_start[:, None] < sel_start[None, :] + SEL_BLOCK) &
               (cmp_start[:, None] + CMP_BLOCK > sel_start[None, :])).astype(jnp.float32)
    imp = jnp.einsum('bgrtn,nj->bgtj', p_cmp, overlap)
    blk_t = pos // SEL_BLOCK
    j = jnp.arange(n_sel)
    valid = j[None, :] <= blk_t[:, None]
    forced = (j[None, :] == 0) | (j[None, :] == blk_t[:, None]) | (j[None, :] == blk_t[:, None] - 1)
    score = jnp.where(valid, imp, -jnp.inf)
    score = jnp.where(forced & valid, jnp.inf, score)
    top_n = min(SEL_TOPN, n_sel)
    _, sel_idx = lax.top_k(score, top_n)
    tok = (sel_idx[..., None] * SEL_BLOCK + jnp.arange(SEL_BLOCK)).reshape(B, G, T, top_n * SEL_BLOCK)
    o_slc = selected_attention(q, k_slc, v_slc, tok, slopes)
    o_win = banded_attention(q, k_win, v_win, slopes, NSA_WINDOW)
    g = gates.astype(q.dtype)
    return g[..., 0:1] * o_cmp + g[..., 1:2] * o_slc + g[..., 2:3] * o_win


def setup_inputs(seed: int = 0) -> dict:
    key = jax.random.key(seed)
    ks = jax.random.split(key, 16)
    n_cols = (N_HEADS_NSA * HEAD_DIM + 6 * N_KV_NSA * HEAD_DIM + N_HEADS_NSA * N_NSA_BRANCHES
              + N_HEADS_SWA * HEAD_DIM + 2 * N_KV_SWA * HEAD_DIM)
    f = jnp.float32
    nrm = lambda k, shape, s: jax.random.normal(k, shape, f) * s
    gain = lambda k: 1.0 + 0.05 * jax.random.normal(k, (DEPTH, D_MODEL), f)
    flat = CMP_BLOCK * HEAD_DIM
    return {
        "x": jax.random.normal(ks[0], (BATCH, SEQ, D_MODEL), f),
        "norm_mix_pre": gain(ks[1]),
        "w_in": nrm(ks[2], (DEPTH, D_MODEL, n_cols), D_MODEL ** -0.5),
        "cmp_pe_k": nrm(ks[3], (DEPTH, CMP_BLOCK, HEAD_DIM), 0.02),
        "cmp_w1_k": nrm(ks[4], (DEPTH, flat, CMP_HIDDEN), flat ** -0.5),
        "cmp_w2_k": nrm(ks[5], (DEPTH, CMP_HIDDEN, HEAD_DIM), CMP_HIDDEN ** -0.5),
        "cmp_pe_v": nrm(ks[6], (DEPTH, CMP_BLOCK, HEAD_DIM), 0.02),
        "cmp_w1_v": nrm(ks[7], (DEPTH, flat, CMP_HIDDEN), flat ** -0.5),
        "cmp_w2_v": nrm(ks[8], (DEPTH, CMP_HIDDEN, HEAD_DIM), CMP_HIDDEN ** -0.5),
        "sinks": nrm(ks[9], (DEPTH, N_KV_SWA, N_HEADS_SWA // N_KV_SWA), 0.5),
        "w_out": nrm(ks[10], (DEPTH, MIX_WIDTH, D_MODEL), MIX_WIDTH ** -0.5),
        "norm_mix_post": gain(ks[11]),
        "norm_mlp_pre": gain(ks[12]),
        "w_up": nrm(ks[13], (DEPTH, D_MODEL, D_FF), D_MODEL ** -0.5),
        "w_down": nrm(ks[14], (DEPTH, D_FF, D_MODEL), D_FF ** -0.5),
        "norm_mlp_post": gain(ks[15]),
    }


def reference(x, norm_mix_pre, w_in, cmp_pe_k, cmp_w1_k, cmp_w2_k, cmp_pe_v, cmp_w1_v, cmp_w2_v,
              sinks, w_out, norm_mix_post, norm_mlp_pre, w_up, w_down, norm_mlp_post):
    B, T, _ = x.shape
    D = HEAD_DIM
    Rn = N_HEADS_NSA // N_KV_NSA
    Rs = N_HEADS_SWA // N_KV_SWA
    slopes_nsa, slopes_swa = alibi_slopes()
    sizes = [N_HEADS_NSA * D] + [N_KV_NSA * D] * 6 + [N_HEADS_NSA * N_NSA_BRANCHES,
             N_HEADS_SWA * D, N_KV_SWA * D, N_KV_SWA * D]
    split_at = list(np.cumsum(sizes)[:-1])

    def to_q(t, G, R):
        return t.reshape(B, T, G, R, D).transpose(0, 2, 3, 1, 4)

    def to_kv(t, G):
        return t.reshape(B, T, G, D).transpose(0, 2, 1, 3)

    h = x
    for i in range(DEPTH):
        a = rms_norm(h, norm_mix_pre[i])
        proj = a @ w_in[i]
        (q_n, kc_n, vc_n, ks_n, vs_n, kw_n, vw_n, g_n, q_s, k_s, v_s) = jnp.split(proj, split_at, axis=-1)
        gates = jax.nn.sigmoid(g_n.astype(jnp.float32)).reshape(B, T, N_KV_NSA, Rn, N_NSA_BRANCHES)
        gates = gates.transpose(0, 2, 3, 1, 4)
        o_nsa = nsa_attention(to_q(q_n, N_KV_NSA, Rn), to_kv(kc_n, N_KV_NSA), to_kv(vc_n, N_KV_NSA),
                              to_kv(ks_n, N_KV_NSA), to_kv(vs_n, N_KV_NSA),
                              to_kv(kw_n, N_KV_NSA), to_kv(vw_n, N_KV_NSA), gates, slopes_nsa,
                              cmp_pe_k[i], cmp_w1_k[i], cmp_w2_k[i], cmp_pe_v[i], cmp_w1_v[i], cmp_w2_v[i])
        o_swa = banded_attention(to_q(q_s, N_KV_SWA, Rs), to_kv(k_s, N_KV_SWA), to_kv(v_s, N_KV_SWA),
                                 slopes_swa, SWA_WINDOW, sinks[i])
        o_nsa = o_nsa.transpose(0, 3, 1, 2, 4).reshape(B, T, N_HEADS_NSA * D)
        o_swa = o_swa.transpose(0, 3, 1, 2, 4).reshape(B, T, N_HEADS_SWA * D)
        mix = jnp.concatenate([o_nsa, o_swa], axis=-1) @ w_out[i]
        h = h + rms_norm(mix, norm_mix_post[i])
        m = rms_norm(h, norm_mlp_pre[i])
        u = jnp.square(jax.nn.relu(m @ w_up[i]))
        h = h + rms_norm(u @ w_down[i], norm_mlp_post[i])
    return h
```

```cpp
#include <hip/hip_runtime.h>
#include <hip/hip_cooperative_groups.h>
#include <cstdio>
namespace cg = cooperative_groups;

typedef unsigned short us;
typedef __attribute__((ext_vector_type(8))) short bf16x8;
typedef __attribute__((ext_vector_type(4))) short s16x4;
typedef __attribute__((ext_vector_type(4))) float f32x4;

#define DI __device__ __forceinline__
#define MFMA16(a, b, c) __builtin_amdgcn_mfma_f32_16x16x32_bf16((a), (b), (c), 0, 0, 0)

constexpr int T = 2048;
constexpr int NTOK = 32768;
constexpr int LDP = 2048;
constexpr int NPH = 9;
#ifndef PH_MASK
#define PH_MASK 0x1ff
#endif
#define PH_ON(k) ((PH_MASK >> (k)) & 1)
constexpr float LOG2E = 1.4426950408889634f;
constexpr float SC2 = 0.125f * 1.4426950408889634f;
constexpr float EPS = 1e-6f;
#define NEG_INF (-__builtin_inff())

constexpr int C_QN = 0, C_KC = 512, C_VC = 640, C_KS = 768, C_VS = 896, C_KW = 1024, C_VW = 1152, C_QS = 1280, C_KSW = 1792, C_VSW = 1920;

struct Params {
  const float *x, *g_mix_pre, *w_in, *pe_k, *w1_k, *w2_k, *pe_v, *w1_v, *w2_v, *sinks, *w_out, *g_mix_post, *g_mlp_pre, *w_up, *w_down, *g_mlp_post;
  float* out;
  us *wt_in, *wt_out, *wt_up, *wt_dn, *w1t_k, *w1t_v, *w2t_k, *w2t_v;
  us *a, *proj, *attn, *u;
  float *gates, *kcf, *vcf;
  int phase_lo, phase_hi;
};

DI us f2bf(float x) { unsigned u = __float_as_uint(x); u += 0x7fffu + ((u >> 16) & 1u); return (us)(u >> 16); }
DI float bf2f(us h) { return __uint_as_float(((unsigned)h) << 16); }
DI int opaque_tid() { int t = threadIdx.x; asm volatile("" : "+v"(t)); return t; }
DI float ex2(float x) { return __builtin_amdgcn_exp2f(x); }
DI float wave_sum(float v) {
#pragma unroll
  for (int o = 32; o >= 1; o >>= 1) v += __shfl_xor(v, o);
  return v;
}
DI s16x4 pack4(float a, float b, float c, float d) { s16x4 r; r[0] = (short)f2bf(a); r[1] = (short)f2bf(b); r[2] = (short)f2bf(c); r[3] = (short)f2bf(d); return r; }

struct ALoadPlain {
  const us* A; int lda; size_t m0;
  DI bf16x8 operator()(int r, int kt, int kc) const { return *(const bf16x8*)(A + (m0 + r) * (size_t)lda + kt * 64 + kc * 8); }
};
struct ALoadCmp {
  const us* base;
  const float* pe;
  DI bf16x8 operator()(int r, int kt, int kc) const {
    int n = r < 126 ? r : 126;
    bf16x8 v = *(const bf16x8*)(base + (size_t)(16 * n + kt) * LDP + kc * 8);
    const float* pp = pe + kt * 64 + kc * 8;
    bf16x8 o;
#pragma unroll
    for (int e = 0; e < 8; ++e) o[e] = (short)f2bf(bf2f((us)v[e]) + pp[e]);
    return o;
  }
};

template <int MW, class AL, class EPI>
DI void gemm_tile(const AL& al, const us* __restrict__ Bt, int ldb, int n0, int nk, const EPI& epi, char* smem) {
  constexpr int BM = MW * 64, NW = 8 / MW, NT = 128 / NW / 16, AI = BM * 8 / 512;
  us(*As)[72] = (us(*)[72])smem;
  us(*Bs)[72] = (us(*)[72])(smem + BM * 72 * 2);
  const int tid = opaque_tid(), lane = tid & 63, wid = tid >> 6, wr = wid / NW, wc = wid % NW, fr = lane & 15, fq = lane >> 4;
  f32x4 acc[4][NT];
#pragma unroll
  for (int m = 0; m < 4; ++m)
#pragma unroll
    for (int n = 0; n < NT; ++n) acc[m][n] = f32x4{0.f, 0.f, 0.f, 0.f};
  bf16x8 ra[AI], rb[2];
#pragma unroll
  for (int i = 0; i < AI; ++i) { int c = tid + 512 * i, r = c >> 3, kc = c & 7; ra[i] = al(r, 0, kc); }
#pragma unroll
  for (int i = 0; i < 2; ++i) { int c = tid + 512 * i, r = c >> 3, kc = c & 7; rb[i] = *(const bf16x8*)(Bt + (size_t)(n0 + r) * ldb + kc * 8); }
  for (int kt = 0; kt < nk; ++kt) {
    __syncthreads();
#pragma unroll
    for (int i = 0; i < AI; ++i) { int c = tid + 512 * i, r = c >> 3, kc = c & 7; *(bf16x8*)&As[r][kc * 8] = ra[i]; }
#pragma unroll
    for (int i = 0; i < 2; ++i) { int c = tid + 512 * i, r = c >> 3, kc = c & 7; *(bf16x8*)&Bs[r][kc * 8] = rb[i]; }
    __syncthreads();
    if (kt + 1 < nk) {
#pragma unroll
      for (int i = 0; i < AI; ++i) { int c = tid + 512 * i, r = c >> 3, kc = c & 7; ra[i] = al(r, kt + 1, kc); }
#pragma unroll
      for (int i = 0; i < 2; ++i) { int c = tid + 512 * i, r = c >> 3, kc = c & 7; rb[i] = *(const bf16x8*)(Bt + (size_t)(n0 + r) * ldb + (kt + 1) * 64 + kc * 8); }
    }
#pragma unroll
    for (int ks = 0; ks < 2; ++ks) {
      bf16x8 af[4], bfr[NT];
#pragma unroll
      for (int m = 0; m < 4; ++m) af[m] = *(const bf16x8*)&As[wr * 64 + m * 16 + fr][ks * 32 + fq * 8];
#pragma unroll
      for (int n = 0; n < NT; ++n) bfr[n] = *(const bf16x8*)&Bs[wc * (NT * 16) + n * 16 + fr][ks * 32 + fq * 8];
#pragma unroll
      for (int m = 0; m < 4; ++m)
#pragma unroll
        for (int n = 0; n < NT; ++n) acc[m][n] = MFMA16(bfr[n], af[m], acc[m][n]);
    }
  }
  __syncthreads();
#pragma unroll
  for (int m = 0; m < 4; ++m)
#pragma unroll
    for (int n = 0; n < NT; ++n) epi(wr * 64 + m * 16 + fr, wc * (NT * 16) + n * 16 + fq * 4, acc[m][n]);
}

struct EpiProj {
  us* proj; float* gates; size_t m0; int n0;
  DI void operator()(int r, int c, f32x4 v) const {
    size_t row = m0 + r; int col = n0 + c;
    if (col < 2048) {
      *(s16x4*)(proj + row * LDP + col) = pack4(v[0], v[1], v[2], v[3]);
    } else if (col < 2072) {
#pragma unroll
      for (int j = 0; j < 4; ++j) gates[row * 24 + (col - 2048) + j] = 1.f / (1.f + __expf(-v[j]));
    }
  }
};
struct EpiStore {
  us* C; int ldc; size_t m0; int n0; int relu2;
  DI void operator()(int r, int c, f32x4 v) const {
    if (relu2) {
#pragma unroll
      for (int j = 0; j < 4; ++j) { float t = v[j] > 0.f ? v[j] : 0.f; v[j] = t * t; }
    }
    *(s16x4*)(C + (m0 + r) * (size_t)ldc + n0 + c) = pack4(v[0], v[1], v[2], v[3]);
  }
};
struct EpiGeluLds {
  us* Hs;
  DI void operator()(int r, int c, f32x4 v) const {
    float o[4];
#pragma unroll
    for (int j = 0; j < 4; ++j) {
      float xx = v[j];
      float t = tanhf(0.7978845608028654f * (xx + 0.044715f * xx * xx * xx));
      o[j] = 0.5f * xx * (1.f + t);
    }
    *(s16x4*)(Hs + r * 136 + c) = pack4(o[0], o[1], o[2], o[3]);
  }
};

DI int remap_win(int n) { return n < 1280 ? n : (n < 1304 ? n + 768 : n - 24); }

DI void transpose_item(const float* __restrict__ src, int K, int N, us* __restrict__ dst, int kt, int nt, bool remap, char* smem) {
  float(*tile)[65] = (float(*)[65])smem;
  const int tid = opaque_tid(), lo = tid & 63, hi = tid >> 6;
  __syncthreads();
#pragma unroll
  for (int i = 0; i < 8; ++i) {
    int kl = i * 8 + hi, n = nt * 64 + lo;
    tile[kl][lo] = (n < N) ? src[(size_t)(kt * 64 + kl) * N + n] : 0.f;
  }
  __syncthreads();
#pragma unroll
  for (int i = 0; i < 8; ++i) {
    int nl = i * 8 + hi, n = nt * 64 + nl;
    if (n < N) {
      int nn = remap ? remap_win(n) : n;
      dst[(size_t)nn * K + kt * 64 + lo] = f2bf(tile[lo][nl]);
    }
  }
}

DI void phase0(const Params& p, char* smem) {
  const int tid = opaque_tid(), lane = tid & 63, wid = tid >> 6;
  for (int it = blockIdx.x; it < 3096; it += gridDim.x) {
    int i = it;
    if (i < 528) { transpose_item(p.w_in, 1024, 2072, p.wt_in, i / 33, i % 33, true, smem); continue; }
    i -= 528;
    if (i < 256) { transpose_item(p.w_out, 1024, 1024, p.wt_out, i / 16, i % 16, false, smem); continue; }
    i -= 256;
    if (i < 1024) { transpose_item(p.w_up, 1024, 4096, p.wt_up, i / 64, i % 64, false, smem); continue; }
    i -= 1024;
    if (i < 1024) { transpose_item(p.w_down, 4096, 1024, p.wt_dn, i / 16, i % 16, false, smem); continue; }
    i -= 1024;
    if (i < 128) { transpose_item(p.w1_k, 2048, 256, p.w1t_k, i / 4, i % 4, false, smem); continue; }
    i -= 128;
    if (i < 128) { transpose_item(p.w1_v, 2048, 256, p.w1t_v, i / 4, i % 4, false, smem); continue; }
    i -= 128;
    if (i < 4) { transpose_item(p.w2_k, 256, 64, p.w2t_k, i, 0, false, smem); continue; }
    i -= 4;
    transpose_item(p.w2_v, 256, 64, p.w2t_v, i, 0, false, smem);
  }
  {
    unsigned* z = (unsigned*)(p.wt_in + (size_t)2072 * 1024);
    for (int i = blockIdx.x * 512 + tid; i < 104 * 512; i += gridDim.x * 512) z[i] = 0u;
    float* kz = p.kcf;
    for (int i = blockIdx.x * 512 + tid; i < 2 * 32 * 128 * 64; i += gridDim.x * 512) kz[i] = 0.f;
  }
  for (int row = blockIdx.x * 8 + wid; row < NTOK; row += gridDim.x * 8) {
    const float4* xr = (const float4*)(p.x + (size_t)row * 1024);
    float4 v[4]; float ss = 0.f;
#pragma unroll
    for (int i = 0; i < 4; ++i) { v[i] = xr[lane + 64 * i]; ss += v[i].x * v[i].x + v[i].y * v[i].y + v[i].z * v[i].z + v[i].w * v[i].w; }
    ss = wave_sum(ss);
    float r = rsqrtf(ss * (1.f / 1024.f) + EPS);
#pragma unroll
    for (int i = 0; i < 4; ++i) {
      float4 g = ((const float4*)p.g_mix_pre)[lane + 64 * i];
      *(s16x4*)(p.a + (size_t)row * 1024 + (lane + 64 * i) * 4) = pack4(v[i].x * r * g.x, v[i].y * r * g.y, v[i].z * r * g.z, v[i].w * r * g.w);
    }
  }
}

template <class MASK>
DI void attn_tile64(const us (*Ks)[72], const us (*Vt)[72], const bf16x8 (&qf)[2][2], f32x4 (&o)[4][2], float (&m)[2], float (&l)[2],
                    const float (&slope2)[2], int key0, int tok, int fr, int fq, const MASK& mask) {
  bf16x8 kf[4][2];
#pragma unroll
  for (int mt = 0; mt < 4; ++mt)
#pragma unroll
    for (int ks = 0; ks < 2; ++ks) kf[mt][ks] = *(const bf16x8*)&Ks[mt * 16 + fr][ks * 32 + fq * 8];
  bf16x8 vf[4][2];
#pragma unroll
  for (int dt = 0; dt < 4; ++dt)
#pragma unroll
    for (int s2 = 0; s2 < 2; ++s2) {
      s16x4 lo = *(const s16x4*)&Vt[dt * 16 + fr][s2 * 32 + fq * 4];
      s16x4 hi = *(const s16x4*)&Vt[dt * 16 + fr][s2 * 32 + 16 + fq * 4];
      vf[dt][s2] = __builtin_shufflevector(lo, hi, 0, 1, 2, 3, 4, 5, 6, 7);
    }
#pragma unroll 1
  for (int nt = 0; nt < 2; ++nt) {
    const bf16x8 q0 = nt ? qf[1][0] : qf[0][0];
    const bf16x8 q1 = nt ? qf[1][1] : qf[0][1];
    const float sl = nt ? slope2[1] : slope2[0];
    const float mold = nt ? m[1] : m[0];
    f32x4 s[4];
#pragma unroll
    for (int mt = 0; mt < 4; ++mt) {
      s[mt] = f32x4{0.f, 0.f, 0.f, 0.f};
      s[mt] = MFMA16(kf[mt][0], q0, s[mt]);
      s[mt] = MFMA16(kf[mt][1], q1, s[mt]);
    }
    float mx = NEG_INF;
#pragma unroll
    for (int mt = 0; mt < 4; ++mt)
#pragma unroll
      for (int j = 0; j < 4; ++j) {
        int key = key0 + mt * 16 + fq * 4 + j;
        int dist = tok - key;
        float v = mask(key, dist) ? (s[mt][j] * SC2 - sl * (float)dist) : NEG_INF;
        s[mt][j] = v;
        mx = fmaxf(mx, v);
      }
    mx = fmaxf(mx, __shfl_xor(mx, 16));
    mx = fmaxf(mx, __shfl_xor(mx, 32));
    float mnew = fmaxf(mold, mx);
    float muse = (mnew == NEG_INF) ? 0.f : mnew;
    float alpha = ex2(mold - muse);
    float ps = 0.f;
#pragma unroll
    for (int mt = 0; mt < 4; ++mt)
#pragma unroll
      for (int j = 0; j < 4; ++j) { float pv = ex2(s[mt][j] - muse); s[mt][j] = pv; ps += pv; }
    bf16x8 pb[2];
#pragma unroll
    for (int s2 = 0; s2 < 2; ++s2) {
      s16x4 lo = pack4(s[2 * s2][0], s[2 * s2][1], s[2 * s2][2], s[2 * s2][3]);
      s16x4 hi = pack4(s[2 * s2 + 1][0], s[2 * s2 + 1][1], s[2 * s2 + 1][2], s[2 * s2 + 1][3]);
      pb[s2] = __builtin_shufflevector(lo, hi, 0, 1, 2, 3, 4, 5, 6, 7);
    }
    f32x4 tmp[4];
#pragma unroll
    for (int dt = 0; dt < 4; ++dt) {
      tmp[dt] = f32x4{0.f, 0.f, 0.f, 0.f};
#pragma unroll
      for (int s2 = 0; s2 < 2; ++s2) tmp[dt] = MFMA16(vf[dt][s2], pb[s2], tmp[dt]);
    }
    if (nt == 0) {
      m[0] = mnew; l[0] = l[0] * alpha + ps;
#pragma unroll
      for (int dt = 0; dt < 4; ++dt) o[dt][0] = o[dt][0] * alpha + tmp[dt];
    } else {
      m[1] = mnew; l[1] = l[1] * alpha + ps;
#pragma unroll
      for (int dt = 0; dt < 4; ++dt) o[dt][1] = o[dt][1] * alpha + tmp[dt];
    }
  }
}

DI void stage_kv64(const us* __restrict__ projb, int key0, int kcol, int vcol, us (*Ks)[72], us (*Vt)[72], int tid) {
  {
    int c = tid, row = c >> 3, ch = c & 7;
    *(bf16x8*)&Ks[row][ch * 8] = *(const bf16x8*)(projb + (size_t)(key0 + row) * LDP + kcol + ch * 8);
  }
  {
    int c = tid, row = c & 63, ch = c >> 6;
    bf16x8 v = *(const bf16x8*)(projb + (size_t)(key0 + row) * LDP + vcol + ch * 8);
#pragma unroll
    for (int e = 0; e < 8; ++e) Vt[ch * 8 + e][row] = (us)v[e];
  }
}

struct MaskBand { int window; DI bool operator()(int key, int dist) const { return dist >= 0 && dist < window; } };
struct MaskSel { bool sel; DI bool operator()(int key, int dist) const { return sel && dist >= 0; } };

DI void banded_item(const Params& p, int b, int g, int tq, int kind, char* smem) {
  us(*Ks)[72] = (us(*)[72])smem;
  us(*Vt)[72] = (us(*)[72])(smem + 64 * 72 * 2);
  const int tid = opaque_tid(), lane = tid & 63, w = tid >> 6, fr = lane & 15, fq = lane >> 4;
  const int tg = w >> 1, hp = w & 1;
  const int t0 = tq * 64, tok = t0 + 16 * tg + fr;
  const int qcol = kind ? C_QS : C_QN, kcol = (kind ? C_KSW : C_KW) + g * 64, vcol = (kind ? C_VSW : C_VW) + g * 64;
  const int window = kind ? 128 : 512;
  const us* projb = p.proj + (size_t)b * T * LDP;
  bf16x8 qf[2][2];
  f32x4 o[4][2];
  float m[2], l[2], slope2[2];
#pragma unroll
  for (int r = 0; r < 2; ++r) {
    int hh = g * 4 + hp * 2 + r;
#pragma unroll
    for (int ks = 0; ks < 2; ++ks) qf[r][ks] = *(const bf16x8*)(projb + (size_t)tok * LDP + qcol + hh * 64 + ks * 32 + fq * 8);
    float sl = kind ? exp2f(-(float)(hh + 1)) : exp2f(-0.5f * (float)(2 * hh + 1));
    slope2[r] = sl * LOG2E;
    if (kind) { m[r] = p.sinks[hh] * LOG2E; l[r] = (fq == 0) ? 1.f : 0.f; }
    else { m[r] = NEG_INF; l[r] = 0.f; }
#pragma unroll
    for (int dt = 0; dt < 4; ++dt) o[dt][r] = f32x4{0.f, 0.f, 0.f, 0.f};
  }
  int kt0 = t0 - window; if (kt0 < 0) kt0 = 0; kt0 >>= 6;
  MaskBand mask{window};
  for (int kt = kt0; kt <= tq; ++kt) {
    __syncthreads();
    stage_kv64(projb, kt * 64, kcol, vcol, Ks, Vt, tid);
    __syncthreads();
    attn_tile64(Ks, Vt, qf, o, m, l, slope2, kt * 64, tok, fr, fq, mask);
  }
  const size_t rowg = (size_t)b * T + tok;
#pragma unroll
  for (int r = 0; r < 2; ++r) {
    float lt = l[r]; lt += __shfl_xor(lt, 16); lt += __shfl_xor(lt, 32);
    float inv = lt > 0.f ? 1.f / lt : 0.f;
    int hh = g * 4 + hp * 2 + r;
    if (!kind) inv *= p.gates[rowg * 24 + hh * 3 + 2];
    us* dst = p.attn + rowg * 1024 + (kind ? 512 : 0) + hh * 64 + fq * 4;
#pragma unroll
    for (int dt = 0; dt < 4; ++dt) *(s16x4*)(dst + dt * 16) = pack4(o[dt][r][0] * inv, o[dt][r][1] * inv, o[dt][r][2] * inv, o[dt][r][3] * inv);
  }
}

DI void compress_item(const Params& p, int item, char* smem) {
  const int nh = item & 1, g = (item >> 1) & 1, b = (item >> 2) & 15, kv = item >> 6;
  const us* base = p.proj + (size_t)b * T * LDP + (kv ? C_VC : C_KC) + g * 64;
  ALoadCmp al{base, kv ? p.pe_v : p.pe_k};
  const us* w1t = kv ? p.w1t_v : p.w1t_k;
  const us* w2t = kv ? p.w2t_v : p.w2t_k;
  float* dst = (kv ? p.vcf : p.kcf) + (size_t)(b * 2 + g) * 128 * 64;
  us* Hs = (us*)smem;
  us* Ws = (us*)(smem + 128 * 136 * 2);
  const int tid = opaque_tid(), lane = tid & 63, w = tid >> 6, fr = lane & 15, fq = lane >> 4;
  EpiGeluLds epi{Hs};
  gemm_tile<2>(al, w1t, 2048, nh * 128, 32, epi, smem);
#pragma unroll
  for (int i = 0; i < 2; ++i) {
    int c = tid + 512 * i, r = c >> 4, ch = c & 15;
    *(bf16x8*)(Ws + r * 136 + ch * 8) = *(const bf16x8*)(w2t + (size_t)r * 256 + nh * 128 + ch * 8);
  }
  __syncthreads();
  f32x4 acc[4];
#pragma unroll
  for (int n = 0; n < 4; ++n) acc[n] = f32x4{0.f, 0.f, 0.f, 0.f};
#pragma unroll
  for (int ks = 0; ks < 4; ++ks) {
    bf16x8 af = *(const bf16x8*)(Hs + (w * 16 + fr) * 136 + ks * 32 + fq * 8);
#pragma unroll
    for (int n = 0; n < 4; ++n) {
      bf16x8 bfr = *(const bf16x8*)(Ws + (n * 16 + fr) * 136 + ks * 32 + fq * 8);
      acc[n] = MFMA16(bfr, af, acc[n]);
    }
  }
#pragma unroll
  for (int n = 0; n < 4; ++n) {
    float* d = dst + (size_t)(w * 16 + fr) * 64 + n * 16 + fq * 4;
#pragma unroll
    for (int j = 0; j < 4; ++j) atomicAdd(d + j, acc[n][j]);
  }
  __syncthreads();
}

DI void cmp_probs(const us* KcS, const bf16x8 (&qfn)[2], float slope2, int tok, int fr, int fq, f32x4 (&s)[8]) {
#pragma unroll
  for (int mt = 0; mt < 8; ++mt) {
    s[mt] = f32x4{0.f, 0.f, 0.f, 0.f};
#pragma unroll
    for (int ks = 0; ks < 2; ++ks) {
      bf16x8 kf = *(const bf16x8*)(KcS + (mt * 16 + fr) * 72 + ks * 32 + fq * 8);
      s[mt] = MFMA16(kf, qfn[ks], s[mt]);
    }
  }
  float mx = NEG_INF;
#pragma unroll
  for (int mt = 0; mt < 8; ++mt)
#pragma unroll
    for (int j = 0; j < 4; ++j) {
      int n = mt * 16 + fq * 4 + j;
      int dist = tok - (16 * n + 31);
      float v = dist >= 0 ? (s[mt][j] * SC2 - slope2 * (float)dist) : NEG_INF;
      s[mt][j] = v;
      mx = fmaxf(mx, v);
    }
  mx = fmaxf(mx, __shfl_xor(mx, 16));
  mx = fmaxf(mx, __shfl_xor(mx, 32));
  float muse = (mx == NEG_INF) ? 0.f : mx;
  float ps = 0.f;
#pragma unroll
  for (int mt = 0; mt < 8; ++mt)
#pragma unroll
    for (int j = 0; j < 4; ++j) { float pv = ex2(s[mt][j] - muse); s[mt][j] = pv; ps += pv; }
  ps += __shfl_xor(ps, 16);
  ps += __shfl_xor(ps, 32);
  float inv = ps > 0.f ? 1.f / ps : 0.f;
#pragma unroll
  for (int mt = 0; mt < 8; ++mt) s[mt] *= inv;
}

DI void nsa_item(const Params& p, int b, int g, int tq, char* smem) {
  us* KcS = (us*)smem;
  us* VcT = (us*)(smem + 18432);
  us(*Ks)[72] = (us(*)[72])(smem + 35840);
  us(*Vt)[72] = (us(*)[72])(smem + 45056);
  float* impS = (float*)(smem + 54272);
  unsigned* unionS = (unsigned*)(smem + 71168);
  const int tid = opaque_tid(), lane = tid & 63, w = tid >> 6, fr = lane & 15, fq = lane >> 4;
  const int tg = w >> 1, hp = w & 1;
  const int t0 = tq * 64, tok = t0 + 16 * tg + fr;
  const us* projb = p.proj + (size_t)b * T * LDP;
  const float* kcf = p.kcf + (size_t)(b * 2 + g) * 128 * 64;
  const float* vcf = p.vcf + (size_t)(b * 2 + g) * 128 * 64;
  __syncthreads();
#pragma unroll
  for (int i = 0; i < 2; ++i) {
    int c = tid + 512 * i, r = c >> 3, ch = c & 7;
    const float4* s4 = (const float4*)(kcf + r * 64 + ch * 8);
    float4 a0 = s4[0], a1 = s4[1];
    s16x4 lo = pack4(a0.x, a0.y, a0.z, a0.w), hi = pack4(a1.x, a1.y, a1.z, a1.w);
    *(bf16x8*)(KcS + r * 72 + ch * 8) = __builtin_shufflevector(lo, hi, 0, 1, 2, 3, 4, 5, 6, 7);
  }
#pragma unroll
  for (int i = 0; i < 2; ++i) {
    int c = tid + 512 * i, n = c & 127, ch = c >> 7;
    const float4* s4 = (const float4*)(vcf + n * 64 + ch * 8);
    float4 a0 = s4[0], a1 = s4[1];
    VcT[(ch * 8 + 0) * 136 + n] = f2bf(a0.x); VcT[(ch * 8 + 1) * 136 + n] = f2bf(a0.y);
    VcT[(ch * 8 + 2) * 136 + n] = f2bf(a0.z); VcT[(ch * 8 + 3) * 136 + n] = f2bf(a0.w);
    VcT[(ch * 8 + 4) * 136 + n] = f2bf(a1.x); VcT[(ch * 8 + 5) * 136 + n] = f2bf(a1.y);
    VcT[(ch * 8 + 6) * 136 + n] = f2bf(a1.z); VcT[(ch * 8 + 7) * 136 + n] = f2bf(a1.w);
  }
  if (tid == 0) *unionS = 0u;
  bf16x8 qf[2][2];
  float slope2[2];
#pragma unroll
  for (int r = 0; r < 2; ++r) {
    int hh = g * 4 + hp * 2 + r;
#pragma unroll
    for (int ks = 0; ks < 2; ++ks) qf[r][ks] = *(const bf16x8*)(projb + (size_t)tok * LDP + C_QN + hh * 64 + ks * 32 + fq * 8);
    slope2[r] = exp2f(-0.5f * (float)(2 * hh + 1)) * LOG2E;
  }
  __syncthreads();
#ifndef NO_P1
  {
    float impacc[8];
#pragma unroll
    for (int mt = 0; mt < 8; ++mt) impacc[mt] = 0.f;
#pragma unroll 1
    for (int nt = 0; nt < 2; ++nt) {
      bf16x8 qn[2];
      qn[0] = nt ? qf[1][0] : qf[0][0];
      qn[1] = nt ? qf[1][1] : qf[0][1];
      f32x4 s[8];
      int frz = fr, fqz = fq, tokz = tok;
      asm volatile("" : "+v"(frz), "+v"(fqz), "+v"(tokz));
      cmp_probs(KcS, qn, nt ? slope2[1] : slope2[0], tokz, frz, fqz, s);
#pragma unroll
      for (int mt = 0; mt < 8; ++mt) {
        float x1 = __shfl(s[mt][3], (lane + 48) & 63);
        float x0 = 0.f;
        if (mt > 0) x0 = __shfl(s[mt - 1][3], (lane + 48) & 63);
        float prev3 = fq > 0 ? x1 : x0;
        impacc[mt] += ((s[mt][0] + s[mt][1]) + (s[mt][2] + s[mt][3])) + prev3;
      }
    }
#pragma unroll
    for (int mt = 0; mt < 8; ++mt) impS[(hp * 64 + tg * 16 + fr) * 33 + mt * 4 + fq] = impacc[mt];
  }
#endif
  __syncthreads();
  unsigned sel;
  {
    const unsigned valid = (tq == 31) ? 0xffffffffu : ((1u << (tq + 1)) - 1u);
    unsigned forced = 1u | (1u << tq);
    if (tq > 0) forced |= 1u << (tq - 1);
    sel = forced & valid;
    int cnt = __popc(sel);
    const float* ip0 = impS + (tg * 16 + fr) * 33;
    const float* ip1 = impS + (64 + tg * 16 + fr) * 33;
    for (int round = 0; round < 8; ++round) {
      if (cnt < 8) {
        unsigned cand = valid & ~sel;
        float best = -1.f; int bi = -1;
#pragma unroll
        for (int j = 0; j < 32; ++j) {
          float v = ip0[j] + ip1[j];
          if (((cand >> j) & 1u) && v > best) { best = v; bi = j; }
        }
        if (bi >= 0) { sel |= 1u << bi; cnt++; }
      }
    }
  }
  atomicOr(unionS, sel);
  __syncthreads();
  const unsigned uni = *unionS;
  f32x4 o[4][2];
  float m[2], l[2];
#pragma unroll
  for (int r = 0; r < 2; ++r) {
    m[r] = NEG_INF; l[r] = 0.f;
#pragma unroll
    for (int dt = 0; dt < 4; ++dt) o[dt][r] = f32x4{0.f, 0.f, 0.f, 0.f};
  }
#ifndef NO_SELLOOP
  for (int j = 0; j <= tq; ++j) {
    if (!((uni >> j) & 1u)) continue;
    __syncthreads();
    stage_kv64(projb, j * 64, C_KS + g * 64, C_VS + g * 64, Ks, Vt, tid);
    __syncthreads();
    MaskSel mask{((sel >> j) & 1u) != 0};
    attn_tile64(Ks, Vt, qf, o, m, l, slope2, j * 64, tok, fr, fq, mask);
  }
#endif
  const size_t rowg = (size_t)b * T + tok;
#pragma unroll
  for (int r = 0; r < 2; ++r) {
    float lt = l[r]; lt += __shfl_xor(lt, 16); lt += __shfl_xor(lt, 32);
    float sc = (lt > 0.f ? 1.f / lt : 0.f) * p.gates[rowg * 24 + (g * 4 + hp * 2 + r) * 3 + 1];
#pragma unroll
    for (int dt = 0; dt < 4; ++dt) o[dt][r] *= sc;
  }
#ifndef NO_P2
#pragma unroll 1
  for (int nt = 0; nt < 2; ++nt) {
    bf16x8 qn[2];
    qn[0] = nt ? qf[1][0] : qf[0][0];
    qn[1] = nt ? qf[1][1] : qf[0][1];
    f32x4 s[8];
    int frz = fr, fqz = fq, tokz = tok;
    asm volatile("" : "+v"(frz), "+v"(fqz), "+v"(tokz));
    cmp_probs(KcS, qn, nt ? slope2[1] : slope2[0], tokz, frz, fqz, s);
    const float g0 = p.gates[rowg * 24 + (g * 4 + hp * 2 + nt) * 3 + 0];
    f32x4 tmp[4];
#pragma unroll
    for (int dt = 0; dt < 4; ++dt) tmp[dt] = f32x4{0.f, 0.f, 0.f, 0.f};
#pragma unroll
    for (int s2 = 0; s2 < 4; ++s2) {
      s16x4 lo = pack4(s[2 * s2][0] * g0, s[2 * s2][1] * g0, s[2 * s2][2] * g0, s[2 * s2][3] * g0);
      s16x4 hi = pack4(s[2 * s2 + 1][0] * g0, s[2 * s2 + 1][1] * g0, s[2 * s2 + 1][2] * g0, s[2 * s2 + 1][3] * g0);
      bf16x8 pb = __builtin_shufflevector(lo, hi, 0, 1, 2, 3, 4, 5, 6, 7);
#pragma unroll
      for (int dt = 0; dt < 4; ++dt) {
        s16x4 vlo = *(const s16x4*)(VcT + (dt * 16 + frz) * 136 + s2 * 32 + fqz * 4);
        s16x4 vhi = *(const s16x4*)(VcT + (dt * 16 + frz) * 136 + s2 * 32 + 16 + fqz * 4);
        bf16x8 vf = __builtin_shufflevector(vlo, vhi, 0, 1, 2, 3, 4, 5, 6, 7);
        tmp[dt] = MFMA16(vf, pb, tmp[dt]);
      }
    }
    if (nt == 0) {
#pragma unroll
      for (int dt = 0; dt < 4; ++dt) o[dt][0] += tmp[dt];
    } else {
#pragma unroll
      for (int dt = 0; dt < 4; ++dt) o[dt][1] += tmp[dt];
    }
  }
#endif
#pragma unroll
  for (int r = 0; r < 2; ++r) {
    us* dst = p.attn + rowg * 1024 + (g * 4 + hp * 2 + r) * 64 + fq * 4;
#pragma unroll
    for (int dt = 0; dt < 4; ++dt) {
      s16x4 old = *(const s16x4*)(dst + dt * 16);
      *(s16x4*)(dst + dt * 16) = pack4(o[dt][r][0] + bf2f((us)old[0]), o[dt][r][1] + bf2f((us)old[1]),
                                       o[dt][r][2] + bf2f((us)old[2]), o[dt][r][3] + bf2f((us)old[3]));
    }
  }
}

DI void phase5(const Params& p) {
  const int lane = threadIdx.x & 63, wid = threadIdx.x >> 6;
  const us* mix = p.a; us* mbuf = p.attn;
  for (int row = blockIdx.x * 8 + wid; row < NTOK; row += gridDim.x * 8) {
    float mv[4][4]; float ss = 0.f;
#pragma unroll
    for (int i = 0; i < 4; ++i) {
      s16x4 t = *(const s16x4*)(mix + (size_t)row * 1024 + (lane + 64 * i) * 4);
#pragma unroll
      for (int j = 0; j < 4; ++j) { mv[i][j] = bf2f((us)t[j]); ss += mv[i][j] * mv[i][j]; }
    }
    ss = wave_sum(ss);
    const float r1 = rsqrtf(ss * (1.f / 1024.f) + EPS);
    float hv[4][4]; float ss2 = 0.f;
#pragma unroll
    for (int i = 0; i < 4; ++i) {
      float4 xv = ((const float4*)(p.x + (size_t)row * 1024))[lane + 64 * i];
      float4 g = ((const float4*)p.g_mix_post)[lane + 64 * i];
      hv[i][0] = xv.x + mv[i][0] * r1 * g.x; hv[i][1] = xv.y + mv[i][1] * r1 * g.y;
      hv[i][2] = xv.z + mv[i][2] * r1 * g.z; hv[i][3] = xv.w + mv[i][3] * r1 * g.w;
#pragma unroll
      for (int j = 0; j < 4; ++j) ss2 += hv[i][j] * hv[i][j];
    }
    ss2 = wave_sum(ss2);
    const float r2 = rsqrtf(ss2 * (1.f / 1024.f) + EPS);
#pragma unroll
    for (int i = 0; i < 4; ++i) {
      ((float4*)(p.out + (size_t)row * 1024))[lane + 64 * i] = float4{hv[i][0], hv[i][1], hv[i][2], hv[i][3]};
      float4 g = ((const float4*)p.g_mlp_pre)[lane + 64 * i];
      *(s16x4*)(mbuf + (size_t)row * 1024 + (lane + 64 * i) * 4) = pack4(hv[i][0] * r2 * g.x, hv[i][1] * r2 * g.y, hv[i][2] * r2 * g.z, hv[i][3] * r2 * g.w);
    }
  }
}
DI void phase8(const Params& p) {
  const int lane = threadIdx.x & 63, wid = threadIdx.x >> 6;
  const us* dn = p.a;
  for (int row = blockIdx.x * 8 + wid; row < NTOK; row += gridDim.x * 8) {
    float mv[4][4]; float ss = 0.f;
#pragma unroll
    for (int i = 0; i < 4; ++i) {
      s16x4 t = *(const s16x4*)(dn + (size_t)row * 1024 + (lane + 64 * i) * 4);
#pragma unroll
      for (int j = 0; j < 4; ++j) { mv[i][j] = bf2f((us)t[j]); ss += mv[i][j] * mv[i][j]; }
    }
    ss = wave_sum(ss);
    const float r1 = rsqrtf(ss * (1.f / 1024.f) + EPS);
#pragma unroll
    for (int i = 0; i < 4; ++i) {
      float4* op = ((float4*)(p.out + (size_t)row * 1024)) + lane + 64 * i;
      float4 hv = *op;
      float4 g = ((const float4*)p.g_mlp_post)[lane + 64 * i];
      hv.x += mv[i][0] * r1 * g.x; hv.y += mv[i][1] * r1 * g.y; hv.z += mv[i][2] * r1 * g.z; hv.w += mv[i][3] * r1 * g.w;
      *op = hv;
    }
  }
}

constexpr int LDS_BYTES = 81920;
__global__ void __launch_bounds__(512) mega(Params p) {
  extern __shared__ __attribute__((aligned(16))) char smem[];
  cg::grid_group grid = cg::this_grid();
  for (int ph = p.phase_lo; ph < p.phase_hi; ++ph) {
    if (ph == 0 && PH_ON(0)) {
      phase0(p, smem);
    } else if (ph == 1 && PH_ON(1)) {
      for (int t = blockIdx.x; t < 128 * 17; t += gridDim.x) {
        int mt = t / 17, nt = t % 17;
        ALoadPlain al{p.a, 1024, (size_t)mt * 256};
        EpiProj epi{p.proj, p.gates, (size_t)mt * 256, nt * 128};
        gemm_tile<4>(al, p.wt_in, 1024, nt * 128, 16, epi, smem);
      }
    } else if (ph == 2 && PH_ON(2)) {
      for (int it = blockIdx.x; it < 128 + 2048; it += gridDim.x) {
#ifndef NO_CMPITEM
        if (it < 128) { compress_item(p, it, smem); continue; }
#endif
#ifndef NO_BANDED
        int i = it - 128;
        int kind = i >= 1024; i &= 1023;
        int tq = 31 - (i >> 5), rem = i & 31;
        banded_item(p, rem >> 1, rem & 1, tq, kind, smem);
#endif
      }
    } else if (ph == 3 && PH_ON(3)) {
      for (int i = blockIdx.x; i < 1024; i += gridDim.x) {
        int tq = 31 - (i >> 5), rem = i & 31;
        nsa_item(p, rem >> 1, rem & 1, tq, smem);
      }
    } else if (ph == 4 && PH_ON(4)) {
      for (int t = blockIdx.x; t < 128 * 8; t += gridDim.x) {
        int mt = t / 8, nt = t % 8;
        ALoadPlain al{p.attn, 1024, (size_t)mt * 256};
        EpiStore epi{p.a, 1024, (size_t)mt * 256, nt * 128, 0};
        gemm_tile<4>(al, p.wt_out, 1024, nt * 128, 16, epi, smem);
      }
    } else if (ph == 5 && PH_ON(5)) {
      phase5(p);
    } else if (ph == 6 && PH_ON(6)) {
      for (int t = blockIdx.x; t < 128 * 32; t += gridDim.x) {
        int mt = t / 32, nt = t % 32;
        ALoadPlain al{p.attn, 1024, (size_t)mt * 256};
        EpiStore epi{p.u, 4096, (size_t)mt * 256, nt * 128, 1};
        gemm_tile<4>(al, p.wt_up, 1024, nt * 128, 16, epi, smem);
      }
    } else if (ph == 7 && PH_ON(7)) {
      for (int t = blockIdx.x; t < 128 * 8; t += gridDim.x) {
        int mt = t / 8, nt = t % 8;
        ALoadPlain al{p.u, 4096, (size_t)mt * 256};
        EpiStore epi{p.a, 1024, (size_t)mt * 256, nt * 128, 0};
        gemm_tile<4>(al, p.wt_dn, 4096, nt * 128, 64, epi, smem);
      }
    } else if (PH_ON(8)) {
      phase8(p);
    }
    if (ph + 1 < p.phase_hi) grid.sync();
  }
}

extern "C" void kernel_launch(void* const* d_in, const int* in_sizes, int n_in, void* d_out, int out_size, void* d_ws, size_t ws_size,
                              hipStream_t stream) {
  static int grid_blocks = 0;
  if (!grid_blocks) {
    int dev = 0, cus = 0, per_cu = 0;
    (void)hipGetDevice(&dev);
    (void)hipDeviceGetAttribute(&cus, hipDeviceAttributeMultiprocessorCount, dev);
    (void)hipFuncSetAttribute((const void*)mega, hipFuncAttributeMaxDynamicSharedMemorySize, LDS_BYTES);
    (void)hipOccupancyMaxActiveBlocksPerMultiprocessor(&per_cu, (const void*)mega, 512, LDS_BYTES);
    if (per_cu < 1) per_cu = 1;
    if (per_cu > 1) per_cu = 1;
    grid_blocks = cus * per_cu;
  }
  Params p{};
  const float* const* in = (const float* const*)d_in;
  p.x = in[0]; p.g_mix_pre = in[1]; p.w_in = in[2]; p.pe_k = in[3]; p.w1_k = in[4]; p.w2_k = in[5]; p.pe_v = in[6]; p.w1_v = in[7];
  p.w2_v = in[8]; p.sinks = in[9]; p.w_out = in[10]; p.g_mix_post = in[11]; p.g_mlp_pre = in[12]; p.w_up = in[13]; p.w_down = in[14];
  p.g_mlp_post = in[15];
  p.out = (float*)d_out;
  char* ws = (char*)d_ws;
  const size_t MB = 1024 * 1024;
  p.a = (us*)(ws);
  p.attn = (us*)(ws + 64 * MB);
  p.proj = (us*)(ws + 128 * MB);
  p.u = (us*)(ws + 128 * MB);
  char* w = ws + 384 * MB;
  p.wt_in = (us*)w;  w += (size_t)2176 * 1024 * 2;
  p.wt_out = (us*)w; w += (size_t)1024 * 1024 * 2;
  p.wt_up = (us*)w;  w += (size_t)4096 * 1024 * 2;
  p.wt_dn = (us*)w;  w += (size_t)4096 * 1024 * 2;
  p.w1t_k = (us*)w;  w += (size_t)256 * 2048 * 2;
  p.w1t_v = (us*)w;  w += (size_t)256 * 2048 * 2;
  p.w2t_k = (us*)w;  w += (size_t)64 * 256 * 2;
  p.w2t_v = (us*)w;  w += (size_t)64 * 256 * 2;
  p.gates = (float*)w; w += (size_t)NTOK * 24 * 4;
  p.kcf = (float*)w; w += (size_t)32 * 128 * 64 * 4;
  p.vcf = (float*)w; w += (size_t)32 * 128 * 64 * 4;
  p.phase_lo = 0; p.phase_hi = NPH;
  void* args[] = {&p};
  hipError_t e = hipLaunchCooperativeKernel((const void*)mega, dim3(grid_blocks), dim3(512), args, LDS_BYTES, stream);
  if (e != hipSuccess) fprintf(stderr, "cooperative launch failed: %s (grid %d)\n", hipGetErrorString(e), grid_blocks);
}
```

```cpp
#include <hip/hip_runtime.h>
#include <hip/hip_cooperative_groups.h>
#include <cstdio>
namespace cg = cooperative_groups;

typedef unsigned short us;
typedef __attribute__((ext_vector_type(8))) short bf16x8;
typedef __attribute__((ext_vector_type(4))) short s16x4;
typedef __attribute__((ext_vector_type(4))) float f32x4;

#define DI __device__ __forceinline__
#define MFMA16(a, b, c) __builtin_amdgcn_mfma_f32_16x16x32_bf16((a), (b), (c), 0, 0, 0)

constexpr int T = 2048;
constexpr int NTOK = 32768;
constexpr int LDP = 2048;
constexpr int NPH = 9;
constexpr float LOG2E = 1.4426950408889634f;
constexpr float SC2 = 0.125f * 1.4426950408889634f;
constexpr float EPS = 1e-6f;
#define NEG_INF (-__builtin_inff())

constexpr int C_QN = 0, C_KC = 512, C_VC = 640, C_KS = 768, C_VS = 896, C_KW = 1024, C_VW = 1152, C_QS = 1280, C_KSW = 1792, C_VSW = 1920;

struct Params {
  const float *x, *g_mix_pre, *w_in, *pe_k, *w1_k, *w2_k, *pe_v, *w1_v, *w2_v, *sinks, *w_out, *g_mix_post, *g_mlp_pre, *w_up, *w_down, *g_mlp_post;
  float* out;
  us *wt_in, *wt_out, *wt_up, *wt_dn, *w1t_k, *w1t_v, *w2t_k, *w2t_v;
  us *a, *proj, *attn, *u;
  float *gates, *kcf, *vcf;
  unsigned* bar;
  int phase_lo, phase_hi;
};

DI us f2bf(float x) { unsigned u = __float_as_uint(x); u += 0x7fffu + ((u >> 16) & 1u); return (us)(u >> 16); }
DI float bf2f(us h) { return __uint_as_float(((unsigned)h) << 16); }
DI int opaque_tid() { int t = threadIdx.x; asm volatile("" : "+v"(t)); return t; }
DI float ex2(float x) { return __builtin_amdgcn_exp2f(x); }
DI float xor16_max(float x) { unsigned u = __float_as_uint(x); auto r = __builtin_amdgcn_permlane16_swap(u, u, false, false); return fmaxf(__uint_as_float(r[0]), __uint_as_float(r[1])); }
DI float xor32_max(float x) { unsigned u = __float_as_uint(x); auto r = __builtin_amdgcn_permlane32_swap(u, u, false, false); return fmaxf(__uint_as_float(r[0]), __uint_as_float(r[1])); }
DI float xor16_sum(float x) { unsigned u = __float_as_uint(x); auto r = __builtin_amdgcn_permlane16_swap(u, u, false, false); return __uint_as_float(r[0]) + __uint_as_float(r[1]); }
DI float xor32_sum(float x) { unsigned u = __float_as_uint(x); auto r = __builtin_amdgcn_permlane32_swap(u, u, false, false); return __uint_as_float(r[0]) + __uint_as_float(r[1]); }
DI s16x4 lds_tr4(const us* p) { return __builtin_amdgcn_ds_read_tr16_b64_v4i16((__attribute__((address_space(3))) s16x4*)p); }
DI float wave_sum(float v) {
#pragma unroll
  for (int o = 32; o >= 1; o >>= 1) v += __shfl_xor(v, o);
  return v;
}
typedef __bf16 bf2_t __attribute__((ext_vector_type(2)));
typedef float f2_t __attribute__((ext_vector_type(2)));
typedef unsigned u32x2 __attribute__((ext_vector_type(2)));
typedef unsigned u32x4 __attribute__((ext_vector_type(4)));
DI unsigned cvt2(float lo, float hi) { f2_t v = {lo, hi}; return __builtin_bit_cast(unsigned, __builtin_convertvector(v, bf2_t)); }
DI s16x4 pack4(float a, float b, float c, float d) { u32x2 r = {cvt2(a, b), cvt2(c, d)}; return __builtin_bit_cast(s16x4, r); }

#define XB_TMO      128
#define XB_XCNT(j)  (256  + 64 * (j))
#define XB_XSUB(j)  (1280 + 64 * (j))
#define XB_XGEN(j)  (2304 + 64 * (j))
#define XB_TOP      3328
#define XB_TOPGEN   3392
#define XCD_BAR_WORDS 3456
#define XB_SPIN_CAP (1u << 18)
#define LAS __attribute__((address_space(3)))

__device__ __forceinline__ unsigned xb_ld(unsigned* p)              { return __hip_atomic_load(p, __ATOMIC_RELAXED, __HIP_MEMORY_SCOPE_AGENT); }
__device__ __forceinline__ unsigned xb_add(unsigned* p, unsigned v) { return __hip_atomic_fetch_add(p, v, __ATOMIC_RELAXED, __HIP_MEMORY_SCOPE_AGENT); }
__device__ __forceinline__ unsigned xb_xcc_id() { return (unsigned)__builtin_amdgcn_s_getreg((3 << 11) | 20) & 0xFu; }
#define XB_SPIN(cond, bar) do { unsigned _sp = 0; while (cond) { __builtin_amdgcn_s_sleep(1); \
    if ((++_sp & 255u) == 0u) { if (xb_ld(&(bar)[XB_TMO])) break; if (_sp > XB_SPIN_CAP) { atomicAdd(&(bar)[XB_TMO], 1u); break; } } } } while (0)

struct XcdBarrier {
    unsigned* bar; unsigned x;
    volatile LAS unsigned* st;
};

__device__ __forceinline__ XcdBarrier xcd_barrier_post(unsigned* bar, volatile LAS unsigned* st) {
    XcdBarrier b; b.bar = bar; b.x = xb_xcc_id(); b.st = st;
    if (threadIdx.x == 0) (void)xb_add(&bar[XB_XCNT(b.x)], 1u);
    return b;
}
__device__ __forceinline__ void xcd_barrier_complete(unsigned* bar, unsigned x, unsigned& nloc, unsigned& nx) {
    const unsigned G = gridDim.x * gridDim.y * gridDim.z;
    unsigned sum, cnt, mine, sp = 0u;
    for (;;) {
        sum = 0u; cnt = 0u; mine = 0u;
#pragma unroll
        for (unsigned j = 0; j < 16; ++j) { const unsigned c = xb_ld(&bar[XB_XCNT(j)]); sum += c; cnt += (c > 0u) ? 1u : 0u; mine = (j == x) ? c : mine; }
        if (sum == G) break;
        __builtin_amdgcn_s_sleep(1);
        if ((++sp & 255u) == 0u) { if (xb_ld(&bar[XB_TMO])) break; if (sp > XB_SPIN_CAP) { atomicAdd(&bar[XB_TMO], 1u); break; } }
    }
    nloc = mine > 0u ? mine : 1u; nx = cnt > 0u ? cnt : 1u;
}

__device__ __forceinline__ void xcd_barrier(const XcdBarrier& b) {
    asm volatile("s_waitcnt vmcnt(0)" ::: "memory");
    __syncthreads();
    if (threadIdx.x == 0) {
        unsigned* bar = b.bar;
        __builtin_amdgcn_s_waitcnt(0);
        unsigned nloc = b.st[0], nx = b.st[1];
        if (nloc == 0u) { xcd_barrier_complete(bar, b.x, nloc, nx); b.st[0] = nloc; b.st[1] = nx; }
        const unsigned old = xb_add(&bar[XB_XSUB(b.x)], 1u);
        const unsigned gen = old / nloc;
        if (old + 1u == (gen + 1u) * nloc) {
            __builtin_amdgcn_fence(__ATOMIC_RELEASE, "agent");
            asm volatile("s_waitcnt vmcnt(0)" ::: "memory");
            const unsigned og = xb_add(&bar[XB_TOP], 1u);
            const unsigned tg = og / nx;
            if (og + 1u == (tg + 1u) * nx) xb_add(&bar[XB_TOPGEN], 1u);
            else XB_SPIN(xb_ld(&bar[XB_TOPGEN]) == tg, bar);
            __builtin_amdgcn_fence(__ATOMIC_ACQUIRE, "agent");
            xb_add(&bar[XB_XGEN(b.x)], 1u);
            asm volatile("s_waitcnt vmcnt(0)" ::: "memory");
        } else {
            XB_SPIN(xb_ld(&bar[XB_XGEN(b.x)]) == gen, bar);
            __builtin_amdgcn_fence(__ATOMIC_ACQUIRE, "agent");
            asm volatile("s_waitcnt vmcnt(0)" ::: "memory");
        }
    }
    __syncthreads();
}


namespace pg8 {
#define PG8_LAS __attribute__((address_space(3)))
typedef unsigned short bf16_t;
typedef short bf16x8 __attribute__((ext_vector_type(8)));
typedef float f32x4 __attribute__((ext_vector_type(4)));
typedef unsigned u32x4 __attribute__((ext_vector_type(4)));
constexpr int BM = 256, BK = 64, HALF = 128, HTB = HALF * BK * 2  , STAGE_BYTES = 8 * HTB, NXCD = 8, WGM = 8;

__host__ __device__ __forceinline__ int lds_byte(int r, int c) { const int st = (r >> 4) * 2 + (c >> 5), rr = r & 15, cc = c & 31, ob = rr * 64 + cc * 2; return st * 1024 + (ob ^ (((ob >> 9) & 1) << 5)); }
__host__ __device__ __forceinline__ void stage_rc(int b, int& R, int& C) { const int st = b / 1024, sb = b % 1024, swz = sb ^ (((sb >> 9) & 1) << 5); R = (st >> 1) * 16 + swz / 64; C = (st & 1) * 32 + (swz % 64) / 2; }
__host__ __device__ __forceinline__ int perm32(int rho) { const int n = rho >> 4, i = rho & 15; return 8 * (i >> 2) + 4 * n + (i & 3); }

struct Unit { int pm, pn; };
struct Gemm { const bf16_t* A; const bf16_t* Bt; int M, N, K; };

struct StaticOrder {
    int nM, nN, nwg, G, c;
    __host__ __device__ void init(int M, int N, int G_, int c_) { nM = M / BM; nN = N / BM; nwg = nM * nN; G = G_; c = c_; }
    __host__ __device__ bool next(int i, Unit& u) const {
        const long L = (long)i * G + c; if (L >= nwg) return false;
        int wgid = (int)L; { const int q = nwg / NXCD, r = nwg % NXCD, xcd = wgid % NXCD, off = wgid / NXCD; wgid = (xcd < r ? xcd * (q + 1) : r * (q + 1) + (xcd - r) * q) + off; }
        const int nig = WGM * nN, gid = wgid / nig, fm = gid * WGM, gsz = (nM - fm) < WGM ? (nM - fm) : WGM;
        u.pm = fm + ((wgid % nig) % gsz); u.pn = (wgid % nig) / gsz; return true;
    }
    __device__ __forceinline__ void a_ready(const Unit&) const {}
    __device__ __forceinline__ void done(const Unit&) const {}
};
template <class Epi, class Sched, bool STAMP = false>
__device__ __forceinline__ void gemm_phase(PG8_LAS unsigned char* lds, const Gemm g, const Sched& S, const Epi& E, unsigned long long* stamps) {
    const int tid = opaque_tid(), wid = __builtin_amdgcn_readfirstlane(tid >> 6), lane = tid & 63, wr = wid >> 2, wc = wid & 3, fr = lane & 15, fq = lane >> 4;
    const int K = g.K, nt = K / BK;
    int ts_lo = 0, ts_hi = 0, nts = 0; const unsigned long long rt_entry = STAMP ? (unsigned long long)wall_clock64() : 0ull;
#define PG8_STAMP() do { if (STAMP && wid == 0 && nts < 64) { const unsigned long long _c = (unsigned long long)clock64(); \
        ts_lo = (lane == nts) ? (int)(unsigned)_c : ts_lo; ts_hi = (lane == nts) ? (int)(unsigned)(_c >> 32) : ts_hi; ++nts; } } while (0)
    PG8_STAMP();
    unsigned voffA[2], voffB[2];
#pragma unroll
    for (int i = 0; i < 2; ++i) { int R, C; stage_rc(tid * 16 + i * 8192, R, C); const int Rb = Epi::PERM ? ((R & ~31) + perm32(R & 31)) : R;
        voffA[i] = (unsigned)(R * K + C) * 2u; voffB[i] = (unsigned)(Rb * K + C) * 2u; }
    const size_t kstep = (size_t)(BK * 2);
    const size_t hstep = (size_t)HALF * K * 2;
    const size_t tstep = 2 * hstep;
    const unsigned ldsw = (unsigned)wid * 1024u;
    const int aoff = lds_byte(wr * 64 + fr, fq * 8), boff = lds_byte(wc * 32 + fr, fq * 8);
#define PG8_SA(b, h) (((b) * 2 + (h)) * HTB)
#define PG8_SB(b, h) ((4 + (b) * 2 + (h)) * HTB)
#define PG8_STAGE(bufoff, gbase, voff) do { _Pragma("unroll") for (int _i = 0; _i < 2; ++_i) \
        __builtin_amdgcn_global_load_lds((const unsigned*)((const char*)(gbase) + (voff)[_i]), (PG8_LAS unsigned*)(lds + (bufoff) + ldsw + _i * 8192), 16, 0, 0); } while (0)
#define PG8_LDA(dst, b, h) do { _Pragma("unroll") for (int m = 0; m < 4; ++m) _Pragma("unroll") for (int k = 0; k < 2; ++k) dst[m][k] = *(const PG8_LAS bf16x8*)(lds + PG8_SA(b, h) + aoff + m * 2048 + k * 1024); } while (0)
#define PG8_LDB(dst, b, h) do { _Pragma("unroll") for (int n = 0; n < 2; ++n) _Pragma("unroll") for (int k = 0; k < 2; ++k) dst[n][k] = *(const PG8_LAS bf16x8*)(lds + PG8_SB(b, h) + boff + n * 2048 + k * 1024); } while (0)
#define PG8_MMA(ai, bj, At, Bt) do { __builtin_amdgcn_s_setprio(1); _Pragma("unroll") for (int m = 0; m < 4; ++m) _Pragma("unroll") for (int n = 0; n < 2; ++n) _Pragma("unroll") for (int k = 0; k < 2; ++k) \
        acc[ai][bj][m][n] = __builtin_amdgcn_mfma_f32_16x16x32_bf16(Bt[n][k], At[m][k], acc[ai][bj][m][n], 0, 0, 0); __builtin_amdgcn_s_setprio(0); } while (0)
#define PG8_WAIT_V(n) asm volatile("s_waitcnt vmcnt(" #n ")" ::: "memory")
#define PG8_WAIT_L(n) asm volatile("s_waitcnt lgkmcnt(" #n ")" ::: "memory")
#define PG8_BAR __builtin_amdgcn_s_barrier()
#define PG8_SCHED __builtin_amdgcn_sched_barrier(0)
    Unit cur, nxt; int ui = 0;
    if (!S.next(0, cur)) return;
    f32x4 acc[2][2][4][2];
#pragma unroll
    for (int a = 0; a < 2; ++a)
#pragma unroll
        for (int b = 0; b < 2; ++b)
#pragma unroll
            for (int m = 0; m < 4; ++m)
#pragma unroll
                for (int n = 0; n < 2; ++n) acc[a][b][m][n] = (f32x4){0.f, 0.f, 0.f, 0.f};
    bf16x8 At[4][2], B0[2][2], B1[2][2];
    const char* cA = (const char*)g.A + (size_t)cur.pm * tstep; const char* cB = (const char*)g.Bt + (size_t)cur.pn * tstep;
    S.a_ready(cur);
    PG8_STAGE(PG8_SB(0, 0), cB, voffB); PG8_STAGE(PG8_SA(0, 0), cA, voffA); PG8_STAGE(PG8_SB(0, 1), cB + hstep, voffB); PG8_STAGE(PG8_SA(0, 1), cA + hstep, voffA);
    if (wr == 1) PG8_BAR;
    PG8_WAIT_V(4); PG8_BAR;
    PG8_STAGE(PG8_SB(1, 0), cB + kstep, voffB); PG8_STAGE(PG8_SA(1, 0), cA + kstep, voffA); PG8_STAGE(PG8_SB(1, 1), cB + hstep + kstep, voffB);
    PG8_WAIT_V(6); PG8_BAR;
    PG8_STAMP();
    for (;;) {
        const bool has_next = S.next(ui + 1, nxt);
        const char* nA = has_next ? (const char*)g.A + (size_t)nxt.pm * tstep : cA; const char* nB = has_next ? (const char*)g.Bt + (size_t)nxt.pn * tstep : cB;
        for (int t = 0; t < nt; t += 2) {
            const bool last = (t == nt - 2);
            const char* a1 = cA + (size_t)(t + 1) * kstep;
            const char* a2 = last ? nA : cA + (size_t)(t + 2) * kstep; const char* b2 = last ? nB : cB + (size_t)(t + 2) * kstep;
            const char* a3 = a2 + kstep; const char* b3 = b2 + kstep;
            if (last && has_next) S.a_ready(nxt);
            PG8_LDB(B0, 0, 0); PG8_SCHED; PG8_LDA(At, 0, 0); PG8_STAGE(PG8_SA(1, 1), a1 + hstep, voffA);
            PG8_WAIT_L(8); PG8_BAR; PG8_WAIT_L(0); PG8_MMA(0, 0, At, B0); PG8_BAR; PG8_SCHED;
            PG8_LDB(B1, 0, 1); PG8_STAGE(PG8_SB(0, 0), b2, voffB);
            PG8_BAR; PG8_WAIT_L(0); PG8_MMA(0, 1, At, B1); PG8_BAR;
            PG8_LDA(At, 0, 1); PG8_STAGE(PG8_SA(0, 0), a2, voffA);
            PG8_BAR; PG8_WAIT_L(0); PG8_MMA(1, 0, At, B0); PG8_BAR; PG8_SCHED;
            PG8_STAGE(PG8_SB(0, 1), b2 + hstep, voffB);
            PG8_WAIT_V(6); PG8_BAR; PG8_MMA(1, 1, At, B1); PG8_BAR;
            PG8_LDB(B0, 1, 0); PG8_SCHED; PG8_LDA(At, 1, 0); PG8_STAGE(PG8_SA(0, 1), a2 + hstep, voffA);
            PG8_WAIT_L(8); PG8_BAR; PG8_WAIT_L(0); PG8_MMA(0, 0, At, B0); PG8_BAR; PG8_SCHED;
            PG8_LDB(B1, 1, 1); PG8_STAGE(PG8_SB(1, 0), b3, voffB);
            PG8_BAR; PG8_WAIT_L(0); PG8_MMA(0, 1, At, B1); PG8_BAR;
            PG8_LDA(At, 1, 1); PG8_STAGE(PG8_SA(1, 0), a3, voffA);
            PG8_BAR; PG8_WAIT_L(0); PG8_MMA(1, 0, At, B0); PG8_BAR; PG8_SCHED;
            PG8_STAGE(PG8_SB(1, 1), b3 + hstep, voffB);
            PG8_WAIT_V(6); PG8_BAR; PG8_MMA(1, 1, At, B1); PG8_BAR;
        }
        PG8_STAMP();
        if constexpr (!Epi::AFTER_DRAIN) { E(acc, cur, wr, wc, fr, fq); S.done(cur); }
        PG8_STAMP();
        if (!has_next) break;
#pragma unroll
        for (int a = 0; a < 2; ++a)
#pragma unroll
            for (int b = 0; b < 2; ++b)
#pragma unroll
                for (int m = 0; m < 4; ++m)
#pragma unroll
                    for (int n = 0; n < 2; ++n) acc[a][b][m][n] = (f32x4){0.f, 0.f, 0.f, 0.f};
        cur = nxt; cA = nA; cB = nB; ++ui;
    }
    PG8_WAIT_V(0);
    if (wr == 0) PG8_BAR;
    PG8_BAR;
    if constexpr (Epi::AFTER_DRAIN) { E.fused(acc, cur, wr, wc, fr, fq, lds, wid, lane); S.done(cur); }
    PG8_STAMP();
    if (STAMP && wid == 0) { stamps[lane] = lane < nts ? (((unsigned long long)(unsigned)ts_hi << 32) | (unsigned)ts_lo) : 0ull;
        if (lane == 62) stamps[62] = rt_entry; if (lane == 63) stamps[63] = (unsigned long long)wall_clock64(); }
#undef PG8_STAMP
#undef PG8_SA
#undef PG8_SB
#undef PG8_STAGE
#undef PG8_LDA
#undef PG8_LDB
#undef PG8_MMA
#undef PG8_WAIT_V
#undef PG8_WAIT_L
#undef PG8_BAR
#undef PG8_SCHED
}
}

struct EpiB16 {
  static constexpr bool PERM = true, AFTER_DRAIN = false;
  us* O; int ldc; int ACT;
  DI void operator()(const f32x4 (&acc)[2][2][4][2], const pg8::Unit& u, int wr, int wc, int fr, int fq) const {
    const int row0 = u.pm * 256 + wr * 64 + fr, col0 = u.pn * 256 + wc * 32 + 8 * fq;
#pragma unroll
    for (int ai = 0; ai < 2; ++ai)
#pragma unroll
      for (int m = 0; m < 4; ++m) {
        us* rowp = O + (size_t)(row0 + ai * 128 + m * 16) * ldc + col0;
#pragma unroll
        for (int bj = 0; bj < 2; ++bj) {
          f32x4 v0 = acc[ai][bj][m][0], v1 = acc[ai][bj][m][1];
          if (ACT == 1) {
#pragma unroll
            for (int j = 0; j < 4; ++j) { float a = fmaxf(v0[j], 0.f), b = fmaxf(v1[j], 0.f); v0[j] = a * a; v1[j] = b * b; }
          }
          u32x4 w = {cvt2(v0[0], v0[1]), cvt2(v0[2], v0[3]), cvt2(v1[0], v1[1]), cvt2(v1[2], v1[3])};
          *(u32x4*)(rowp + bj * 128) = w;
        }
      }
  }
};

struct ALoadCmp {
  const us* base;
  const float* pe;
  int r0;
  DI bf16x8 operator()(int r, int kt, int kc) const {
    int n = r + r0; n = n < 126 ? n : 126;
    bf16x8 v = *(const bf16x8*)(base + (size_t)(16 * n + kt) * LDP + kc * 8);
    const float* pp = pe + kt * 64 + kc * 8;
    bf16x8 o;
#pragma unroll
    for (int e = 0; e < 8; ++e) o[e] = (short)f2bf(bf2f((us)v[e]) + pp[e]);
    return o;
  }
};

template <int MW, class AL, class EPI>
DI void gemm_tile(const AL& al, const us* __restrict__ Bt, int ldb, int n0, int nk  , const EPI& epi, char* smem) {
  constexpr int BM = MW * 64, NW = 8 / MW, NT = 128 / NW / 16, AI = BM * 8 / 512, STG = (BM + 128) * 80;
  us(*As)[80] = (us(*)[80])smem;
  us(*Bs)[80] = (us(*)[80])(smem + BM * 80 * 2);
  const int tid = opaque_tid(), lane = tid & 63, wid = tid >> 6, wr = wid / NW, wc = wid % NW, fr = lane & 15, fq = lane >> 4;
  f32x4 acc[4][NT];
#pragma unroll
  for (int m = 0; m < 4; ++m)
#pragma unroll
    for (int n = 0; n < NT; ++n) acc[m][n] = f32x4{0.f, 0.f, 0.f, 0.f};
  bf16x8 ra0[AI], rb0[2], ra1[AI], rb1[2];
#define GT_LOAD(RA, RB, KT) do { \
    _Pragma("unroll") for (int i = 0; i < AI; ++i) { int c = tid + 512 * i, r = c >> 3, kc = c & 7; RA[i] = al(r, (KT), kc); } \
    _Pragma("unroll") for (int i = 0; i < 2; ++i) { int c = tid + 512 * i, r = c >> 3, kc = c & 7; RB[i] = *(const bf16x8*)(Bt + (size_t)(n0 + r) * ldb + (KT) * 64 + kc * 8); } } while (0)
#define GT_STORE(RA, RB, S) do { \
    _Pragma("unroll") for (int i = 0; i < AI; ++i) { int c = tid + 512 * i, r = c >> 3, kc = c & 7; *(bf16x8*)&As[(S) * (BM + 128) + r][kc * 8] = RA[i]; } \
    _Pragma("unroll") for (int i = 0; i < 2; ++i) { int c = tid + 512 * i, r = c >> 3, kc = c & 7; *(bf16x8*)&Bs[(S) * (BM + 128) + r][kc * 8] = RB[i]; } } while (0)
#define GT_COMPUTE(S) do { \
    _Pragma("unroll") for (int ks = 0; ks < 2; ++ks) { \
      bf16x8 af[4], bfr[NT]; \
      _Pragma("unroll") for (int m = 0; m < 4; ++m) af[m] = *(const bf16x8*)&As[(S) * (BM + 128) + wr * 64 + m * 16 + fr][ks * 32 + fq * 8]; \
      _Pragma("unroll") for (int n = 0; n < NT; ++n) bfr[n] = *(const bf16x8*)&Bs[(S) * (BM + 128) + wc * (NT * 16) + n * 16 + fr][ks * 32 + fq * 8]; \
      _Pragma("unroll") for (int m = 0; m < 4; ++m) _Pragma("unroll") for (int n = 0; n < NT; ++n) acc[m][n] = MFMA16(bfr[n], af[m], acc[m][n]); } } while (0)
  GT_LOAD(ra0, rb0, 0);
  GT_LOAD(ra1, rb1, 1);
  __syncthreads();
  GT_STORE(ra0, rb0, 0);
  __syncthreads();
  for (int kt = 0; kt < nk; kt += 2) {
    if (kt + 2 < nk) GT_LOAD(ra0, rb0, kt + 2);
    GT_COMPUTE(0);
    GT_STORE(ra1, rb1, 1);
    __syncthreads();
    if (kt + 3 < nk) GT_LOAD(ra1, rb1, kt + 3);
    GT_COMPUTE(1);
    if (kt + 2 < nk) GT_STORE(ra0, rb0, 0);
    __syncthreads();
  }
#undef GT_LOAD
#undef GT_STORE
#undef GT_COMPUTE
#pragma unroll
  for (int m = 0; m < 4; ++m)
#pragma unroll
    for (int n = 0; n < NT; ++n) epi(wr * 64 + m * 16 + fr, wc * (NT * 16) + n * 16 + fq * 4, acc[m][n]);
}

struct EpiGeluLds {
  us* Hs;
  DI void operator()(int r, int c, f32x4 v) const {
    float o[4];
#pragma unroll
    for (int j = 0; j < 4; ++j) {
      float xx = v[j];
      float t = tanhf(0.7978845608028654f * (xx + 0.044715f * xx * xx * xx));
      o[j] = 0.5f * xx * (1.f + t);
    }
    *(s16x4*)(Hs + r * 136 + c) = pack4(o[0], o[1], o[2], o[3]);
  }
};

DI int remap_win(int n) { return n < 1280 ? n : (n < 1304 ? n + 768 : n - 24); }

DI void transpose_wave(const float* __restrict__ src, int K, int N, us* __restrict__ dst, int kt, int nt, bool remap, int lane) {
  const int n = nt * 64 + lane;
  const bool ok = n < N;
  const float* sp = src + (size_t)(kt * 64) * N + (ok ? n : 0);
  float v[64];
#pragma unroll
  for (int k = 0; k < 64; ++k) v[k] = __builtin_nontemporal_load(sp + (size_t)k * N);
  if (ok) {
    const int nn = remap ? remap_win(n) : n;
    u32x4* dp = (u32x4*)(dst + (size_t)nn * K + kt * 64);
#pragma unroll
    for (int q = 0; q < 8; ++q) {
      u32x4 w = {cvt2(v[8 * q], v[8 * q + 1]), cvt2(v[8 * q + 2], v[8 * q + 3]), cvt2(v[8 * q + 4], v[8 * q + 5]), cvt2(v[8 * q + 6], v[8 * q + 7])};
      dp[q] = w;
    }
  }
}

DI void phase0(const Params& p, char* smem) {
  const int tid = opaque_tid(), lane = tid & 63, wid = tid >> 6;
  const int gw = blockIdx.x * 8 + wid, nw = gridDim.x * 8;
  for (int it = gw; it < 792; it += nw) {
    int i = it;
    if (i < 528) { transpose_wave(p.w_in, 1024, 2072, p.wt_in, i / 33, i % 33, true, lane); continue; }
    i -= 528;
    if (i < 128) { transpose_wave(p.w1_k, 2048, 256, p.w1t_k, i / 4, i % 4, false, lane); continue; }
    i -= 128;
    if (i < 128) { transpose_wave(p.w1_v, 2048, 256, p.w1t_v, i / 4, i % 4, false, lane); continue; }
    i -= 128;
    if (i < 4) { transpose_wave(p.w2_k, 256, 64, p.w2t_k, i, 0, false, lane); continue; }
    i -= 4;
    transpose_wave(p.w2_v, 256, 64, p.w2t_v, i, 0, false, lane);
  }
  {
    unsigned* z = (unsigned*)(p.wt_in + (size_t)2072 * 1024);
    for (int i = blockIdx.x * 512 + tid; i < 104 * 512; i += gridDim.x * 512) z[i] = 0u;
    float* kz = p.kcf;
    for (int i = blockIdx.x * 512 + tid; i < 2 * 32 * 128 * 64; i += gridDim.x * 512) kz[i] = 0.f;
  }
  for (int row = gw * 2; row < NTOK; row += nw * 2) {
    float4 v[2][4];
#pragma unroll
    for (int r = 0; r < 2; ++r)
#pragma unroll
      for (int i = 0; i < 4; ++i) { f32x4 t = __builtin_nontemporal_load(((const f32x4*)(p.x + (size_t)(row + r) * 1024)) + lane + 64 * i); v[r][i] = float4{t[0], t[1], t[2], t[3]}; }
    float4 g[4];
#pragma unroll
    for (int i = 0; i < 4; ++i) g[i] = ((const float4*)p.g_mix_pre)[lane + 64 * i];
#pragma unroll
    for (int r = 0; r < 2; ++r) {
      float ss = 0.f;
#pragma unroll
      for (int i = 0; i < 4; ++i) ss += v[r][i].x * v[r][i].x + v[r][i].y * v[r][i].y + v[r][i].z * v[r][i].z + v[r][i].w * v[r][i].w;
      ss = wave_sum(ss);
      const float rs = rsqrtf(ss * (1.f / 1024.f) + EPS);
#pragma unroll
      for (int i = 0; i < 4; ++i)
        *(s16x4*)(p.a + (size_t)(row + r) * 1024 + (lane + 64 * i) * 4) =
            pack4(v[r][i].x * rs * g[i].x, v[r][i].y * rs * g[i].y, v[r][i].z * rs * g[i].z, v[r][i].w * rs * g[i].w);
    }
  }
}

DI void attn_tile64(const us (*Ks)[80], const us (*Vt)[80], const bf16x8 (&qf)[2][2], f32x4 (&o)[4][2], float (&M)[2], float (&l)[2],
                    const float (&sl2)[2], const float (&qs)[2], const f32x4 (&idxf)[4], int key0, int tok, int fr, int fq,
                    int mode, int window, bool sel) {
  bf16x8 kf[4][2];
#pragma unroll
  for (int mt = 0; mt < 4; ++mt)
#pragma unroll
    for (int ks = 0; ks < 2; ++ks) kf[mt][ks] = *(const bf16x8*)&Ks[mt * 16 + fr][ks * 32 + fq * 8];
  bf16x8 vf[4][2];
#pragma unroll
  for (int dt = 0; dt < 4; ++dt)
#pragma unroll
    for (int s2 = 0; s2 < 2; ++s2) {
      s16x4 lo = lds_tr4(&Vt[s2 * 32 + fq * 4 + (fr >> 2)][dt * 16 + (fr & 3) * 4]);
      s16x4 hi = lds_tr4(&Vt[s2 * 32 + 16 + fq * 4 + (fr >> 2)][dt * 16 + (fr & 3) * 4]);
      vf[dt][s2] = __builtin_shufflevector(lo, hi, 0, 1, 2, 3, 4, 5, 6, 7);
    }
  const float Df = (float)(tok - key0);
  const float thr = (mode == 2) ? Df - (float)window : Df;
#pragma unroll
  for (int nt = 0; nt < 2; ++nt) {
    const bf16x8 q0 = nt ? qf[1][0] : qf[0][0];
    const bf16x8 q1 = nt ? qf[1][1] : qf[0][1];
    const float sl = nt ? sl2[1] : sl2[0];
    const float qsn = nt ? qs[1] : qs[0];
    const float Mold = nt ? M[1] : M[0];
    f32x4 s[4];
    __builtin_amdgcn_s_setprio(1);
#pragma unroll
    for (int mt = 0; mt < 4; ++mt) {
      s[mt] = f32x4{0.f, 0.f, 0.f, 0.f};
      s[mt] = MFMA16(kf[mt][0], q0, s[mt]);
      s[mt] = MFMA16(kf[mt][1], q1, s[mt]);
    }
    __builtin_amdgcn_s_setprio(0);
#pragma unroll
    for (int mt = 0; mt < 4; ++mt) s[mt] = s[mt] * qsn + idxf[mt];
    if (mode == 1) {
#pragma unroll
      for (int mt = 0; mt < 4; ++mt)
#pragma unroll
        for (int j = 0; j < 4; ++j) s[mt][j] = (idxf[mt][j] <= thr) ? s[mt][j] : NEG_INF;
    } else if (mode == 2) {
#pragma unroll
      for (int mt = 0; mt < 4; ++mt)
#pragma unroll
        for (int j = 0; j < 4; ++j) s[mt][j] = (idxf[mt][j] > thr) ? s[mt][j] : NEG_INF;
    }
    float mx = fmaxf(fmaxf(s[0][0], s[0][1]), fmaxf(s[0][2], s[0][3]));
#pragma unroll
    for (int mt = 1; mt < 4; ++mt) mx = fmaxf(fmaxf(mx, s[mt][0]), fmaxf(fmaxf(s[mt][1], s[mt][2]), s[mt][3]));
    mx = xor16_max(mx);
    mx = xor32_max(mx);
    mx = sel ? mx - Df : NEG_INF;
    const float Mnew = fmaxf(Mold, mx);
    const float Muse = (Mnew == NEG_INF) ? 0.f : Mnew;
    const float alpha = ex2(sl * (Mold - Muse));
    const float c = sel ? -sl * (Df + Muse) : NEG_INF;
    float ps = 0.f;
#pragma unroll
    for (int mt = 0; mt < 4; ++mt) {
      s[mt] = s[mt] * sl + c;
#pragma unroll
      for (int j = 0; j < 4; ++j) s[mt][j] = ex2(s[mt][j]);
    }
    {
      f32x4 t = (s[0] + s[1]) + (s[2] + s[3]);
      ps = (t[0] + t[1]) + (t[2] + t[3]);
    }
    bf16x8 pb[2];
#pragma unroll
    for (int s2 = 0; s2 < 2; ++s2) {
      s16x4 lo = pack4(s[2 * s2][0], s[2 * s2][1], s[2 * s2][2], s[2 * s2][3]);
      s16x4 hi = pack4(s[2 * s2 + 1][0], s[2 * s2 + 1][1], s[2 * s2 + 1][2], s[2 * s2 + 1][3]);
      pb[s2] = __builtin_shufflevector(lo, hi, 0, 1, 2, 3, 4, 5, 6, 7);
    }
    const bool resc = __ballot(alpha != 1.f) != 0ull;
    if (nt == 0) {
      M[0] = Mnew; l[0] = l[0] * alpha + ps;
      if (resc) {
#pragma unroll
        for (int dt = 0; dt < 4; ++dt) o[dt][0] *= alpha;
      }
      __builtin_amdgcn_s_setprio(1);
#pragma unroll
      for (int dt = 0; dt < 4; ++dt)
#pragma unroll
        for (int s2 = 0; s2 < 2; ++s2) o[dt][0] = MFMA16(vf[dt][s2], pb[s2], o[dt][0]);
      __builtin_amdgcn_s_setprio(0);
    } else {
      M[1] = Mnew; l[1] = l[1] * alpha + ps;
      if (resc) {
#pragma unroll
        for (int dt = 0; dt < 4; ++dt) o[dt][1] *= alpha;
      }
      __builtin_amdgcn_s_setprio(1);
#pragma unroll
      for (int dt = 0; dt < 4; ++dt)
#pragma unroll
        for (int s2 = 0; s2 < 2; ++s2) o[dt][1] = MFMA16(vf[dt][s2], pb[s2], o[dt][1]);
      __builtin_amdgcn_s_setprio(0);
    }
  }
}

DI void load_kv64(const us* __restrict__ projb, int key0, int kcol, int vcol, int tid, bf16x8& kr, bf16x8& vr) {
  const us* rp = projb + (size_t)(key0 + (tid >> 3)) * LDP + (tid & 7) * 8;
  kr = *(const bf16x8*)(rp + kcol);
  vr = *(const bf16x8*)(rp + vcol);
}
DI void store_kv64(us (*Ks)[80], us (*Vt)[80], int tid, const bf16x8& kr, const bf16x8& vr) {
  *(bf16x8*)&Ks[tid >> 3][(tid & 7) * 8] = kr;
  *(bf16x8*)&Vt[tid >> 3][(tid & 7) * 8] = vr;
}

DI void banded_item(const Params& p, int b, int g, int tq, int kind, char* smem) {
  us(*Ks)[80] = (us(*)[80])smem;
  us(*Vt)[80] = (us(*)[80])(smem + 2 * 64 * 80 * 2);
  const int tid = opaque_tid(), lane = tid & 63, w = tid >> 6, fr = lane & 15, fq = lane >> 4;
  const int tg = w >> 1, hp = w & 1;
  const int t0 = tq * 64, tok = t0 + 16 * tg + fr;
  const int qcol = kind ? C_QS : C_QN, kcol = (kind ? C_KSW : C_KW) + g * 64, vcol = (kind ? C_VSW : C_VW) + g * 64;
  const int window = kind ? 128 : 512;
  const us* projb = p.proj + (size_t)b * T * LDP;
  bf16x8 qf[2][2];
  f32x4 o[4][2];
  float m[2], l[2], slope2[2], qs[2];
  f32x4 idxf[4];
#pragma unroll
  for (int mt = 0; mt < 4; ++mt)
#pragma unroll
    for (int j = 0; j < 4; ++j) idxf[mt][j] = (float)(mt * 16 + fq * 4 + j);
#pragma unroll
  for (int r = 0; r < 2; ++r) {
    int hh = g * 4 + hp * 2 + r;
#pragma unroll
    for (int ks = 0; ks < 2; ++ks) qf[r][ks] = __builtin_nontemporal_load((const bf16x8*)(projb + (size_t)tok * LDP + qcol + hh * 64 + ks * 32 + fq * 8));
    float sl = kind ? exp2f(-(float)(hh + 1)) : exp2f(-0.5f * (float)(2 * hh + 1));
    slope2[r] = sl * LOG2E;
    qs[r] = SC2 / slope2[r];
    if (kind) { m[r] = p.sinks[hh] * LOG2E / slope2[r]; l[r] = (fq == 0) ? 1.f : 0.f; }
    else { m[r] = NEG_INF; l[r] = 0.f; }
#pragma unroll
    for (int dt = 0; dt < 4; ++dt) o[dt][r] = f32x4{0.f, 0.f, 0.f, 0.f};
  }
  int kt0 = t0 - window; if (kt0 < 0) kt0 = 0; kt0 >>= 6;
  {
    bf16x8 kr, vr;
    load_kv64(projb, tq * 64, kcol, vcol, tid, kr, vr);
    __syncthreads();
    store_kv64(Ks, Vt, tid, kr, vr);
    __syncthreads();
    int cur = 0;
    for (int kt = tq; kt >= kt0; --kt) {
      const bool more = kt > kt0;
      if (more) load_kv64(projb, (kt - 1) * 64, kcol, vcol, tid, kr, vr);
      const int mode = (kt == tq) ? 1 : ((64 * (tq - kt) + 63 >= window) ? 2 : 0);
      attn_tile64(Ks + cur * 64, Vt + cur * 64, qf, o, m, l, slope2, qs, idxf, kt * 64, tok, fr, fq, mode, window, true);
      if (more) store_kv64(Ks + (cur ^ 1) * 64, Vt + (cur ^ 1) * 64, tid, kr, vr);
      __syncthreads();
      cur ^= 1;
    }
  }
  const size_t rowg = (size_t)b * T + tok;
#pragma unroll
  for (int r = 0; r < 2; ++r) {
    float lt = l[r]; lt = xor16_sum(lt); lt = xor32_sum(lt);
    float inv = lt > 0.f ? 1.f / lt : 0.f;
    int hh = g * 4 + hp * 2 + r;
    if (!kind) inv *= p.gates[rowg * 24 + hh * 3 + 2];
    us* dst = p.attn + rowg * 1024 + (kind ? 512 : 0) + hh * 64 + fq * 4;
#pragma unroll
    for (int dt = 0; dt < 4; ++dt) *(s16x4*)(dst + dt * 16) = pack4(o[dt][r][0] * inv, o[dt][r][1] * inv, o[dt][r][2] * inv, o[dt][r][3] * inv);
  }
}

DI void compress_item(const Params& p, int item, char* smem) {
  const int mh = item & 1, nh = (item >> 1) & 1, g = (item >> 2) & 1, b = (item >> 3) & 15, kv = item >> 7;
  const us* base = p.proj + (size_t)b * T * LDP + (kv ? C_VC : C_KC) + g * 64;
  ALoadCmp al{base, kv ? p.pe_v : p.pe_k, mh * 64};
  const us* w1t = kv ? p.w1t_v : p.w1t_k;
  const us* w2t = kv ? p.w2t_v : p.w2t_k;
  float* dst = (kv ? p.vcf : p.kcf) + (size_t)(b * 2 + g) * 128 * 64 + (size_t)mh * 64 * 64;
  us* Hs = (us*)smem;
  us* Ws = (us*)(smem + 64 * 136 * 2);
  const int tid = opaque_tid(), lane = tid & 63, w = tid >> 6, fr = lane & 15, fq = lane >> 4;
  EpiGeluLds epi{Hs};
  gemm_tile<1>(al, w1t, 2048, nh * 128, 32, epi, smem);
#pragma unroll
  for (int i = 0; i < 2; ++i) {
    int c = tid + 512 * i, r = c >> 4, ch = c & 15;
    *(bf16x8*)(Ws + r * 136 + ch * 8) = *(const bf16x8*)(w2t + (size_t)r * 256 + nh * 128 + ch * 8);
  }
  __syncthreads();
  const int mrow = (w & 3) * 16, n0 = (w >> 2) * 2;
  f32x4 acc[2];
#pragma unroll
  for (int n = 0; n < 2; ++n) acc[n] = f32x4{0.f, 0.f, 0.f, 0.f};
#pragma unroll
  for (int ks = 0; ks < 4; ++ks) {
    bf16x8 af = *(const bf16x8*)(Hs + (mrow + fr) * 136 + ks * 32 + fq * 8);
#pragma unroll
    for (int n = 0; n < 2; ++n) {
      bf16x8 bfr = *(const bf16x8*)(Ws + ((n0 + n) * 16 + fr) * 136 + ks * 32 + fq * 8);
      acc[n] = MFMA16(bfr, af, acc[n]);
    }
  }
#pragma unroll
  for (int n = 0; n < 2; ++n) {
    float* d = dst + (size_t)(mrow + fr) * 64 + (n0 + n) * 16 + fq * 4;
#pragma unroll
    for (int j = 0; j < 4; ++j) atomicAdd(d + j, acc[n][j]);
  }
  __syncthreads();
}

DI void cmp_probs(const us* KcS, const bf16x8 (&qfn)[2], float slope2, int tok, int fr, int fq, int npair, f32x4 (&s)[8]) {
  float mx = NEG_INF;
#pragma unroll
  for (int pr = 0; pr < 4; ++pr) {
    if (pr < npair) {
#pragma unroll
      for (int h = 0; h < 2; ++h) {
        const int mt = pr * 2 + h;
        s[mt] = f32x4{0.f, 0.f, 0.f, 0.f};
#pragma unroll
        for (int ks = 0; ks < 2; ++ks) {
          bf16x8 kf = *(const bf16x8*)(KcS + (mt * 16 + fr) * 80 + ks * 32 + fq * 8);
          s[mt] = MFMA16(kf, qfn[ks], s[mt]);
        }
      }
#pragma unroll
      for (int h = 0; h < 2; ++h) {
        const int mt = pr * 2 + h;
#pragma unroll
        for (int j = 0; j < 4; ++j) {
          int n = mt * 16 + fq * 4 + j;
          int dist = tok - (16 * n + 31);
          float v = dist >= 0 ? (s[mt][j] * SC2 - slope2 * (float)dist) : NEG_INF;
          s[mt][j] = v;
          mx = fmaxf(mx, v);
        }
      }
    }
  }
  mx = xor16_max(mx);
  mx = xor32_max(mx);
  float muse = (mx == NEG_INF) ? 0.f : mx;
  float ps = 0.f;
#pragma unroll
  for (int pr = 0; pr < 4; ++pr) {
    if (pr < npair) {
#pragma unroll
      for (int h = 0; h < 2; ++h)
#pragma unroll
        for (int j = 0; j < 4; ++j) { float pv = ex2(s[pr * 2 + h][j] - muse); s[pr * 2 + h][j] = pv; ps += pv; }
    } else {
      s[pr * 2] = f32x4{0.f, 0.f, 0.f, 0.f}; s[pr * 2 + 1] = f32x4{0.f, 0.f, 0.f, 0.f};
    }
  }
  ps = xor16_sum(ps);
  ps = xor32_sum(ps);
  float inv = ps > 0.f ? 1.f / ps : 0.f;
#pragma unroll
  for (int mt = 0; mt < 8; ++mt) s[mt] *= inv;
}

DI void nsa_item(const Params& p, int b, int g, int tq, char* smem) {
  us* KcS = (us*)smem;
  us* VcT = (us*)(smem + 20480);
  us(*Ks)[80] = (us(*)[80])(smem + 40960);
  us(*Vt)[80] = (us(*)[80])(smem + 61440);
  float* impS = (float*)(smem + 81920);
  float* impL = (float*)(smem + 98816);
  unsigned* unionS = (unsigned*)(smem + 115712);
  u32x4* ocS = (u32x4*)smem;
  const int tid = opaque_tid(), lane = tid & 63, w = tid >> 6, fr = lane & 15, fq = lane >> 4;
  const int tg = w >> 1, hp = w & 1;
  const int t0 = tq * 64, tok = t0 + 16 * tg + fr;
  const us* projb = p.proj + (size_t)b * T * LDP;
  const float* kcf = p.kcf + (size_t)(b * 2 + g) * 128 * 64;
  const float* vcf = p.vcf + (size_t)(b * 2 + g) * 128 * 64;
  const size_t rowg = (size_t)b * T + tok;
  int npair = ((tq * 4 + 2) >> 5) + 1; if (npair > 4) npair = 4;
  const int nrows = npair * 32;
  __syncthreads();
#pragma unroll
  for (int i = 0; i < 2; ++i) {
    int c = tid + 512 * i, r = c >> 3, ch = c & 7;
    if (r >= nrows) continue;
    const float4* s4 = (const float4*)(kcf + r * 64 + ch * 8);
    float4 a0 = s4[0], a1 = s4[1];
    s16x4 lo = pack4(a0.x, a0.y, a0.z, a0.w), hi = pack4(a1.x, a1.y, a1.z, a1.w);
    *(bf16x8*)(KcS + r * 80 + ch * 8) = __builtin_shufflevector(lo, hi, 0, 1, 2, 3, 4, 5, 6, 7);
  }
#pragma unroll
  for (int i = 0; i < 2; ++i) {
    int c = tid + 512 * i, r = c >> 3, ch = c & 7;
    if (r >= nrows) continue;
    const float4* s4 = (const float4*)(vcf + r * 64 + ch * 8);
    float4 a0 = s4[0], a1 = s4[1];
    s16x4 lo = pack4(a0.x, a0.y, a0.z, a0.w), hi = pack4(a1.x, a1.y, a1.z, a1.w);
    *(bf16x8*)(VcT + r * 80 + ch * 8) = __builtin_shufflevector(lo, hi, 0, 1, 2, 3, 4, 5, 6, 7);
  }
  if (tid == 0) *unionS = 0u;
  bf16x8 qf[2][2];
  float slope2[2];
#pragma unroll
  for (int r = 0; r < 2; ++r) {
    int hh = g * 4 + hp * 2 + r;
#pragma unroll
    for (int ks = 0; ks < 2; ++ks) qf[r][ks] = __builtin_nontemporal_load((const bf16x8*)(projb + (size_t)tok * LDP + C_QN + hh * 64 + ks * 32 + fq * 8));
    slope2[r] = exp2f(-0.5f * (float)(2 * hh + 1)) * LOG2E;
  }
  __syncthreads();
  u32x4 ocp[4];
  {
    float accA[8], accL[8];
#pragma unroll
    for (int mt = 0; mt < 8; ++mt) { accA[mt] = 0.f; accL[mt] = 0.f; }
#pragma unroll 1
    for (int nt = 0; nt < 2; ++nt) {
      bf16x8 qn[2];
      qn[0] = nt ? qf[1][0] : qf[0][0];
      qn[1] = nt ? qf[1][1] : qf[0][1];
      f32x4 s[8];
      int frz = fr, fqz = fq, tokz = tok;
      asm volatile("" : "+v"(frz), "+v"(fqz), "+v"(tokz));
      cmp_probs(KcS, qn, nt ? slope2[1] : slope2[0], tokz, frz, fqz, npair, s);
#pragma unroll
      for (int mt = 0; mt < 8; ++mt) {
        accA[mt] += (s[mt][0] + s[mt][1]) + (s[mt][2] + s[mt][3]);
        accL[mt] += s[mt][3];
      }
      const float g0 = p.gates[rowg * 24 + (g * 4 + hp * 2 + nt) * 3 + 0];
      f32x4 tmp[4];
#pragma unroll
      for (int dt = 0; dt < 4; ++dt) tmp[dt] = f32x4{0.f, 0.f, 0.f, 0.f};
#pragma unroll
      for (int s2 = 0; s2 < 4; ++s2) {
        if (s2 >= npair) continue;
        s16x4 lo = pack4(s[2 * s2][0], s[2 * s2][1], s[2 * s2][2], s[2 * s2][3]);
        s16x4 hi = pack4(s[2 * s2 + 1][0], s[2 * s2 + 1][1], s[2 * s2 + 1][2], s[2 * s2 + 1][3]);
        bf16x8 pb = __builtin_shufflevector(lo, hi, 0, 1, 2, 3, 4, 5, 6, 7);
#pragma unroll
        for (int dt = 0; dt < 4; ++dt) {
          s16x4 vlo = lds_tr4(VcT + (s2 * 32 + fqz * 4 + (frz >> 2)) * 80 + dt * 16 + (frz & 3) * 4);
          s16x4 vhi = lds_tr4(VcT + (s2 * 32 + 16 + fqz * 4 + (frz >> 2)) * 80 + dt * 16 + (frz & 3) * 4);
          bf16x8 vf = __builtin_shufflevector(vlo, vhi, 0, 1, 2, 3, 4, 5, 6, 7);
          tmp[dt] = MFMA16(vf, pb, tmp[dt]);
        }
      }
      u32x4 lo4 = {cvt2(tmp[0][0] * g0, tmp[0][1] * g0), cvt2(tmp[0][2] * g0, tmp[0][3] * g0), cvt2(tmp[1][0] * g0, tmp[1][1] * g0), cvt2(tmp[1][2] * g0, tmp[1][3] * g0)};
      u32x4 hi4 = {cvt2(tmp[2][0] * g0, tmp[2][1] * g0), cvt2(tmp[2][2] * g0, tmp[2][3] * g0), cvt2(tmp[3][0] * g0, tmp[3][1] * g0), cvt2(tmp[3][2] * g0, tmp[3][3] * g0)};
      if (nt == 0) { ocp[0] = lo4; ocp[1] = hi4; } else { ocp[2] = lo4; ocp[3] = hi4; }
    }
    float* ia = impS + (hp * 64 + tg * 16 + fr) * 33;
    float* il = impL + (hp * 64 + tg * 16 + fr) * 33;
#pragma unroll
    for (int mt = 0; mt < 8; ++mt) {
      const int j = mt * 4 + fq;
      ia[j] = accA[mt];
      if (j < 31) il[j + 1] = accL[mt]; else il[0] = 0.f;
    }
  }
  __syncthreads();
#pragma unroll
  for (int q = 0; q < 4; ++q) ocS[q * 512 + tid] = ocp[q];
  unsigned sel;
  {
    const unsigned valid = (tq == 31) ? 0xffffffffu : ((1u << (tq + 1)) - 1u);
    unsigned forced = 1u | (1u << tq);
    if (tq > 0) forced |= 1u << (tq - 1);
    sel = forced & valid;
    int cnt = __popc(sel);
    float cand[8];
    {
      const float* a0 = impS + (tg * 16 + fr) * 33, *a1 = impS + (64 + tg * 16 + fr) * 33;
      const float* l0 = impL + (tg * 16 + fr) * 33, *l1 = impL + (64 + tg * 16 + fr) * 33;
#pragma unroll
      for (int mt = 0; mt < 8; ++mt) { const int j = mt * 4 + fq; cand[mt] = (a0[j] + a1[j]) + (l0[j] + l1[j]); }
    }
    for (int round = 0; round < 8; ++round) {
      if (cnt < 8) {
        const unsigned open = valid & ~sel;
        float bv = -1.f; int bj = 64;
#pragma unroll
        for (int mt = 0; mt < 8; ++mt) {
          const int j = mt * 4 + fq;
          if (((open >> j) & 1u) && cand[mt] > bv) { bv = cand[mt]; bj = j; }
        }
#pragma unroll
        for (int step = 0; step < 2; ++step) {
          const unsigned uv = __float_as_uint(bv), uj = (unsigned)bj;
          float v0, v1; int j0, j1;
          if (step == 0) {
            auto rv = __builtin_amdgcn_permlane16_swap(uv, uv, false, false); auto rj = __builtin_amdgcn_permlane16_swap(uj, uj, false, false);
            v0 = __uint_as_float(rv[0]); v1 = __uint_as_float(rv[1]); j0 = (int)rj[0]; j1 = (int)rj[1];
          } else {
            auto rv = __builtin_amdgcn_permlane32_swap(uv, uv, false, false); auto rj = __builtin_amdgcn_permlane32_swap(uj, uj, false, false);
            v0 = __uint_as_float(rv[0]); v1 = __uint_as_float(rv[1]); j0 = (int)rj[0]; j1 = (int)rj[1];
          }
          const bool take1 = (v1 > v0) || (v1 == v0 && j1 < j0);
          bv = take1 ? v1 : v0; bj = take1 ? j1 : j0;
        }
        if (bj < 32) { sel |= 1u << bj; cnt++; }
      }
    }
  }
  atomicOr(unionS, sel);
  f32x4 o[4][2];
  float m[2], l[2], qs[2];
  f32x4 idxf[4];
#pragma unroll
  for (int mt = 0; mt < 4; ++mt)
#pragma unroll
    for (int j = 0; j < 4; ++j) idxf[mt][j] = (float)(mt * 16 + fq * 4 + j);
#pragma unroll
  for (int r = 0; r < 2; ++r) {
    qs[r] = SC2 / slope2[r];
    m[r] = NEG_INF; l[r] = 0.f;
#pragma unroll
    for (int dt = 0; dt < 4; ++dt) o[dt][r] = f32x4{0.f, 0.f, 0.f, 0.f};
  }
  {
    const int kcol = C_KW + g * 64, vcol = C_VW + g * 64;
    int kt0 = t0 - 512; if (kt0 < 0) kt0 = 0; kt0 >>= 6;
    bf16x8 kr, vr;
    load_kv64(projb, tq * 64, kcol, vcol, tid, kr, vr);
    store_kv64(Ks, Vt, tid, kr, vr);
    __syncthreads();
    int cur = 0;
    for (int kt = tq; kt >= kt0; --kt) {
      const bool more = kt > kt0;
      if (more) load_kv64(projb, (kt - 1) * 64, kcol, vcol, tid, kr, vr);
      const int mode = (kt == tq) ? 1 : ((64 * (tq - kt) + 63 >= 512) ? 2 : 0);
      attn_tile64(Ks + cur * 64, Vt + cur * 64, qf, o, m, l, slope2, qs, idxf, kt * 64, tok, fr, fq, mode, 512, true);
      if (more) store_kv64(Ks + (cur ^ 1) * 64, Vt + (cur ^ 1) * 64, tid, kr, vr);
      __syncthreads();
      cur ^= 1;
    }
#pragma unroll
    for (int r = 0; r < 2; ++r) {
      float lt = l[r]; lt = xor16_sum(lt); lt = xor32_sum(lt);
      const float sc = (lt > 0.f ? 1.f / lt : 0.f) * p.gates[rowg * 24 + (g * 4 + hp * 2 + r) * 3 + 2];
#pragma unroll
      for (int half = 0; half < 2; ++half) {
        u32x4 oc = ocS[(r * 2 + half) * 512 + tid];
#pragma unroll
        for (int d2 = 0; d2 < 2; ++d2) {
          const int dt = half * 2 + d2;
          const unsigned c01 = oc[d2 * 2], c23 = oc[d2 * 2 + 1];
          oc[d2 * 2] = cvt2(o[dt][r][0] * sc + bf2f((us)(c01 & 0xffffu)), o[dt][r][1] * sc + bf2f((us)(c01 >> 16)));
          oc[d2 * 2 + 1] = cvt2(o[dt][r][2] * sc + bf2f((us)(c23 & 0xffffu)), o[dt][r][3] * sc + bf2f((us)(c23 >> 16)));
        }
        ocS[(r * 2 + half) * 512 + tid] = oc;
      }
      m[r] = NEG_INF; l[r] = 0.f;
#pragma unroll
      for (int dt = 0; dt < 4; ++dt) o[dt][r] = f32x4{0.f, 0.f, 0.f, 0.f};
    }
  }
  const unsigned uni = *unionS;
  {
    unsigned rem = uni;
    int j = 31 - __clz(rem); rem &= ~(1u << j);
    bf16x8 kr, vr;
    load_kv64(projb, j * 64, C_KS + g * 64, C_VS + g * 64, tid, kr, vr);
    store_kv64(Ks, Vt, tid, kr, vr);
    __syncthreads();
    int cur = 0;
    while (true) {
      const bool more = rem != 0u;
      const int jn = more ? (31 - __clz(rem)) : 0;
      if (more) rem &= ~(1u << jn);
      if (more) load_kv64(projb, jn * 64, C_KS + g * 64, C_VS + g * 64, tid, kr, vr);
      {
        const bool selj = ((sel >> j) & 1u) != 0;
        if (__ballot(selj) != 0ull)
          attn_tile64(Ks + cur * 64, Vt + cur * 64, qf, o, m, l, slope2, qs, idxf, j * 64, tok, fr, fq, (j == tq) ? 1 : 0, 0, selj);
      }
      if (more) store_kv64(Ks + (cur ^ 1) * 64, Vt + (cur ^ 1) * 64, tid, kr, vr);
      __syncthreads();
      if (!more) break;
      cur ^= 1; j = jn;
    }
  }
#pragma unroll
  for (int r = 0; r < 2; ++r) {
    float lt = l[r]; lt = xor16_sum(lt); lt = xor32_sum(lt);
    const float sc = (lt > 0.f ? 1.f / lt : 0.f) * p.gates[rowg * 24 + (g * 4 + hp * 2 + r) * 3 + 1];
    us* dst = p.attn + rowg * 1024 + (g * 4 + hp * 2 + r) * 64 + fq * 4;
#pragma unroll
    for (int half = 0; half < 2; ++half) {
      const u32x4 oc = ocS[(r * 2 + half) * 512 + tid];
#pragma unroll
      for (int d2 = 0; d2 < 2; ++d2) {
        const int dt = half * 2 + d2;
        const unsigned c01 = oc[d2 * 2], c23 = oc[d2 * 2 + 1];
        *(s16x4*)(dst + dt * 16) = pack4(o[dt][r][0] * sc + bf2f((us)(c01 & 0xffffu)), o[dt][r][1] * sc + bf2f((us)(c01 >> 16)),
                                         o[dt][r][2] * sc + bf2f((us)(c23 & 0xffffu)), o[dt][r][3] * sc + bf2f((us)(c23 >> 16)));
      }
    }
  }
}

DI void phase5(const Params& p) {
  const int tid = opaque_tid(), lane = tid & 63, wid = tid >> 6;
  const us* mix = p.a; us* mbuf = p.attn;
  for (int row = (blockIdx.x * 8 + wid) * 2; row < NTOK; row += gridDim.x * 16) {
    s16x4 mt[2][4]; float4 xv[2][4];
#pragma unroll
    for (int r = 0; r < 2; ++r)
#pragma unroll
      for (int i = 0; i < 4; ++i) {
        mt[r][i] = __builtin_nontemporal_load((const s16x4*)(mix + (size_t)(row + r) * 1024 + (lane + 64 * i) * 4));
        { f32x4 t = __builtin_nontemporal_load(((const f32x4*)(p.x + (size_t)(row + r) * 1024)) + lane + 64 * i); xv[r][i] = float4{t[0], t[1], t[2], t[3]}; }
      }
#pragma unroll
    for (int r = 0; r < 2; ++r) {
      float mv[4][4]; float ss = 0.f;
#pragma unroll
      for (int i = 0; i < 4; ++i)
#pragma unroll
        for (int j = 0; j < 4; ++j) { mv[i][j] = bf2f((us)mt[r][i][j]); ss += mv[i][j] * mv[i][j]; }
      ss = wave_sum(ss);
      const float r1 = rsqrtf(ss * (1.f / 1024.f) + EPS);
      float hv[4][4]; float ss2 = 0.f;
#pragma unroll
      for (int i = 0; i < 4; ++i) {
        float4 g = ((const float4*)p.g_mix_post)[lane + 64 * i];
        hv[i][0] = xv[r][i].x + mv[i][0] * r1 * g.x; hv[i][1] = xv[r][i].y + mv[i][1] * r1 * g.y;
        hv[i][2] = xv[r][i].z + mv[i][2] * r1 * g.z; hv[i][3] = xv[r][i].w + mv[i][3] * r1 * g.w;
#pragma unroll
        for (int j = 0; j < 4; ++j) ss2 += hv[i][j] * hv[i][j];
      }
      ss2 = wave_sum(ss2);
      const float r2 = rsqrtf(ss2 * (1.f / 1024.f) + EPS);
#pragma unroll
      for (int i = 0; i < 4; ++i) {
        float4 g = ((const float4*)p.g_mlp_pre)[lane + 64 * i];
        *(s16x4*)(mbuf + (size_t)(row + r) * 1024 + (lane + 64 * i) * 4) = pack4(hv[i][0] * r2 * g.x, hv[i][1] * r2 * g.y, hv[i][2] * r2 * g.z, hv[i][3] * r2 * g.w);
      }
    }
  }
}
DI void phase8(const Params& p) {
  const int tid = opaque_tid(), lane = tid & 63, wid = tid >> 6;
  const us* mix = p.a; const us* dn = p.attn;
  for (int row = (blockIdx.x * 8 + wid) * 2; row < NTOK; row += gridDim.x * 16) {
    s16x4 mt[2][4], dt[2][4]; float4 xv[2][4];
#pragma unroll
    for (int r = 0; r < 2; ++r)
#pragma unroll
      for (int i = 0; i < 4; ++i) {
        mt[r][i] = __builtin_nontemporal_load((const s16x4*)(mix + (size_t)(row + r) * 1024 + (lane + 64 * i) * 4));
        dt[r][i] = __builtin_nontemporal_load((const s16x4*)(dn + (size_t)(row + r) * 1024 + (lane + 64 * i) * 4));
        { f32x4 t = __builtin_nontemporal_load(((const f32x4*)(p.x + (size_t)(row + r) * 1024)) + lane + 64 * i); xv[r][i] = float4{t[0], t[1], t[2], t[3]}; }
      }
#pragma unroll
    for (int r = 0; r < 2; ++r) {
      float ss = 0.f, sd = 0.f;
#pragma unroll
      for (int i = 0; i < 4; ++i)
#pragma unroll
        for (int j = 0; j < 4; ++j) { float a = bf2f((us)mt[r][i][j]), b = bf2f((us)dt[r][i][j]); ss += a * a; sd += b * b; }
      ss = wave_sum(ss); sd = wave_sum(sd);
      const float r1 = rsqrtf(ss * (1.f / 1024.f) + EPS), r3 = rsqrtf(sd * (1.f / 1024.f) + EPS);
#pragma unroll
      for (int i = 0; i < 4; ++i) {
        float4 g1 = ((const float4*)p.g_mix_post)[lane + 64 * i];
        float4 g4 = ((const float4*)p.g_mlp_post)[lane + 64 * i];
        float4 h = xv[r][i];
        h.x = (h.x + bf2f((us)mt[r][i][0]) * r1 * g1.x) + bf2f((us)dt[r][i][0]) * r3 * g4.x;
        h.y = (h.y + bf2f((us)mt[r][i][1]) * r1 * g1.y) + bf2f((us)dt[r][i][1]) * r3 * g4.y;
        h.z = (h.z + bf2f((us)mt[r][i][2]) * r1 * g1.z) + bf2f((us)dt[r][i][2]) * r3 * g4.z;
        h.w = (h.w + bf2f((us)mt[r][i][3]) * r1 * g1.w) + bf2f((us)dt[r][i][3]) * r3 * g4.w;
        __builtin_nontemporal_store(f32x4{h.x, h.y, h.z, h.w}, ((f32x4*)(p.out + (size_t)(row + r) * 1024)) + lane + 64 * i);
      }
    }
  }
}

DI void late_weights_item(const Params& p, int item) {
  const int tid = opaque_tid(), lane = tid & 63, wid = tid >> 6;
  int i = item * 8 + wid;
  if (i < 256) { transpose_wave(p.w_out, 1024, 1024, p.wt_out, i / 16, i % 16, false, lane); return; }
  i -= 256;
  if (i < 1024) { transpose_wave(p.w_up, 1024, 4096, p.wt_up, i / 64, i % 64, false, lane); return; }
  i -= 1024;
  transpose_wave(p.w_down, 4096, 1024, p.wt_dn, i / 16, i % 16, false, lane);
}

DI void gates_rows(const Params& p, int row0, char* smem) {
  const int tid = opaque_tid(), lane = tid & 63, w = tid >> 6, fr = lane & 15, fq = lane >> 4;
  us* Bs = (us*)smem;
  __syncthreads();
#pragma unroll
  for (int i = 0; i < 8; ++i) {
    int c = tid + 512 * i, r = c >> 7, ch = c & 127;
    *(bf16x8*)(Bs + r * 1032 + ch * 8) = *(const bf16x8*)(p.wt_in + (size_t)(2048 + r) * 1024 + ch * 8);
  }
  __syncthreads();
  const us* ap = p.a + (size_t)(row0 + w * 16 + fr) * 1024 + fq * 8;
  const us* bp = Bs + fr * 1032 + fq * 8;
  f32x4 acc[2] = {f32x4{0.f, 0.f, 0.f, 0.f}, f32x4{0.f, 0.f, 0.f, 0.f}};
#pragma unroll 8
  for (int ks = 0; ks < 32; ++ks) {
    bf16x8 af = *(const bf16x8*)(ap + ks * 32);
    bf16x8 b0 = *(const bf16x8*)(bp + ks * 32);
    bf16x8 b1 = *(const bf16x8*)(bp + 16 * 1032 + ks * 32);
    acc[0] = MFMA16(b0, af, acc[0]);
    acc[1] = MFMA16(b1, af, acc[1]);
  }
  float* gp = p.gates + (size_t)(row0 + w * 16 + fr) * 24;
#pragma unroll
  for (int n = 0; n < 2; ++n) {
    if (n == 0 || fq < 2) {
      f32x4 o;
#pragma unroll
      for (int j = 0; j < 4; ++j) o[j] = 1.f / (1.f + __expf(-acc[n][j]));
      *(f32x4*)(gp + n * 16 + fq * 4) = o;
    }
  }
}

constexpr int LDS_BYTES = 131072 + 16;
__global__ void __launch_bounds__(512, 2) mega(Params p) {
  extern __shared__ __attribute__((aligned(16))) char smem[];
  cg::grid_group grid = cg::this_grid();
  if (p.phase_hi > NPH) grid.sync();
  volatile LAS unsigned* xst = (volatile LAS unsigned*)(smem + 131072);
  if (threadIdx.x < 4) xst[threadIdx.x] = 0u;
  __syncthreads();
  const XcdBarrier xb = xcd_barrier_post(p.bar, xst);
  for (int ph = p.phase_lo; ph < p.phase_hi; ++ph) {
    const bool is_gemm = (ph == 1) | (ph == 4) | (ph == 6) | (ph == 7);
    if (is_gemm) {
      const us* A = (ph == 1) ? p.a : (ph == 7 ? p.u : p.attn);
      const us* Bt = (ph == 1) ? p.wt_in : (ph == 4 ? p.wt_out : (ph == 6 ? p.wt_up : p.wt_dn));
      us* O = (ph == 1) ? p.proj : (ph == 6 ? p.u : (ph == 4 ? p.a : p.attn));
      const int N = (ph == 1) ? 2048 : (ph == 6 ? 4096 : 1024);
      const int K = (ph == 7) ? 4096 : 1024;
      pg8::StaticOrder S; S.init(NTOK, N, (int)gridDim.x, (int)blockIdx.x);
      pg8::Gemm g{A, Bt, NTOK, N, K};
      EpiB16 E{O, N, ph == 6 ? 1 : 0};
      pg8::gemm_phase<EpiB16, pg8::StaticOrder, false>((PG8_LAS unsigned char*)smem, g, S, E, nullptr);
      if (ph == 1)
        for (int r0 = blockIdx.x * 128; r0 < NTOK; r0 += gridDim.x * 128) gates_rows(p, r0, smem);
    } else if (ph == 0) {
      phase0(p, smem);
    } else if (ph == 2 || ph == 3) {
      volatile LAS int* qslot = (volatile LAS int*)(smem + 131072 + 8);
      unsigned* ctr = p.bar + 3584 + (ph - 2) * 64;
      const int nitems = (ph == 2) ? 256 : (1024 + 1024 + 288);
      int it = blockIdx.x;
      while (it < nitems) {
        int nx = 0;
        if (threadIdx.x == 0) nx = (int)gridDim.x + (int)atomicAdd(ctr, 1u);
        if (ph == 2) {
          compress_item(p, it, smem);
        } else if (it < 1024) {
          int g = 1 - (it >> 9), r9 = it & 511;
          nsa_item(p, r9 & 15, g, 31 - (r9 >> 4), smem);
        } else if (it < 2048) {
          int i = it - 1024;
          int tq = 31 - (i >> 5), rem = i & 31;
          banded_item(p, rem >> 1, rem & 1, tq, 1, smem);
        } else {
          late_weights_item(p, it - 2048);
        }
        if (threadIdx.x == 0) *qslot = nx;
        __syncthreads();
        it = *qslot;
        __syncthreads();
      }
    } else if (ph == 5) {
      phase5(p);
    } else {
      phase8(p);
    }
    if (ph + 1 < p.phase_hi) xcd_barrier(xb);
  }
}

extern "C" void kernel_launch(void* const* d_in, const int* in_sizes, int n_in, void* d_out, int out_size, void* d_ws, size_t ws_size,
                              hipStream_t stream) {
  static int grid_blocks = 0;
  if (!grid_blocks) {
    int dev = 0, cus = 0, per_cu = 0;
    (void)hipGetDevice(&dev);
    (void)hipDeviceGetAttribute(&cus, hipDeviceAttributeMultiprocessorCount, dev);
    (void)hipFuncSetAttribute((const void*)mega, hipFuncAttributeMaxDynamicSharedMemorySize, LDS_BYTES);
    (void)hipOccupancyMaxActiveBlocksPerMultiprocessor(&per_cu, (const void*)mega, 512, LDS_BYTES);
    if (per_cu < 1) per_cu = 1;
    if (per_cu > 1) per_cu = 1;
    grid_blocks = cus * per_cu;
  }
  Params p{};
  const float* const* in = (const float* const*)d_in;
  p.x = in[0]; p.g_mix_pre = in[1]; p.w_in = in[2]; p.pe_k = in[3]; p.w1_k = in[4]; p.w2_k = in[5]; p.pe_v = in[6]; p.w1_v = in[7];
  p.w2_v = in[8]; p.sinks = in[9]; p.w_out = in[10]; p.g_mix_post = in[11]; p.g_mlp_pre = in[12]; p.w_up = in[13]; p.w_down = in[14];
  p.g_mlp_post = in[15];
  p.out = (float*)d_out;
  char* ws = (char*)d_ws;
  const size_t MB = 1024 * 1024;
  p.a = (us*)(ws);
  p.attn = (us*)(ws + 64 * MB);
  p.proj = (us*)(ws + 128 * MB);
  p.u = (us*)(ws + 128 * MB);
  char* w = ws + 384 * MB;
  p.wt_in = (us*)w;  w += (size_t)2176 * 1024 * 2;
  p.wt_out = (us*)w; w += (size_t)1024 * 1024 * 2;
  p.wt_up = (us*)w;  w += (size_t)4096 * 1024 * 2;
  p.wt_dn = (us*)w;  w += (size_t)4096 * 1024 * 2;
  p.w1t_k = (us*)w;  w += (size_t)256 * 2048 * 2;
  p.w1t_v = (us*)w;  w += (size_t)256 * 2048 * 2;
  p.w2t_k = (us*)w;  w += (size_t)64 * 256 * 2;
  p.w2t_v = (us*)w;  w += (size_t)64 * 256 * 2;
  p.gates = (float*)w; w += (size_t)NTOK * 24 * 4;
  p.kcf = (float*)w; w += (size_t)32 * 128 * 64 * 4;
  p.vcf = (float*)w; w += (size_t)32 * 128 * 64 * 4;
  p.bar = (unsigned*)w; w += 16384;
  (void)hipMemsetAsync(p.bar, 0, 16384, stream);
  p.phase_lo = 0; p.phase_hi = NPH;
  void* args[] = {&p};
  hipError_t e = hipLaunchCooperativeKernel((const void*)mega, dim3(grid_blocks), dim3(512), args, LDS_BYTES, stream);
  if (e != hipSuccess) fprintf(stderr, "cooperative launch failed: %s (grid %d)\n", hipGetErrorString(e), grid_blocks);
}
```

```cpp
#include <hip/hip_runtime.h>
#include <hip/hip_cooperative_groups.h>
#include <cstdio>
namespace cg = cooperative_groups;

typedef unsigned short us;
typedef __attribute__((ext_vector_type(8))) short bf16x8;
typedef __attribute__((ext_vector_type(4))) short s16x4;
typedef __attribute__((ext_vector_type(4))) float f32x4;

#define DI __device__ __forceinline__
#define MFMA16(a, b, c) __builtin_amdgcn_mfma_f32_16x16x32_bf16((a), (b), (c), 0, 0, 0)

constexpr int T = 2048;
constexpr int NTOK = 32768;
constexpr int LDP = 2048;
constexpr int NPH = 9;
constexpr float LOG2E = 1.4426950408889634f;
constexpr float SC2 = 0.125f * 1.4426950408889634f;
constexpr float EPS = 1e-6f;
#define NEG_INF (-__builtin_inff())

constexpr int C_QN = 0, C_KC = 512, C_VC = 640, C_KS = 768, C_VS = 896, C_KW = 1024, C_VW = 1152, C_QS = 1280, C_KSW = 1792, C_VSW = 1920;

struct Params {
  const float *x, *g_mix_pre, *w_in, *pe_k, *w1_k, *w2_k, *pe_v, *w1_v, *w2_v, *sinks, *w_out, *g_mix_post, *g_mlp_pre, *w_up, *w_down, *g_mlp_post;
  float* out;
  us *wt_in, *wt_out, *wt_up, *wt_dn, *w1t_k, *w1t_v, *w2t_k, *w2t_v;
  us *a, *proj, *attn, *u;
  float *gates, *kcf, *vcf;
  unsigned* bar;
  int phase_lo, phase_hi;
};

DI us f2bf(float x) { unsigned u = __float_as_uint(x); u += 0x7fffu + ((u >> 16) & 1u); return (us)(u >> 16); }
DI float bf2f(us h) { return __uint_as_float(((unsigned)h) << 16); }
DI int opaque_tid() { int t = threadIdx.x; asm volatile("" : "+v"(t)); return t; }
DI float ex2(float x) { return __builtin_amdgcn_exp2f(x); }
DI float xor16_max(float x) { unsigned u = __float_as_uint(x); auto r = __builtin_amdgcn_permlane16_swap(u, u, false, false); return fmaxf(__uint_as_float(r[0]), __uint_as_float(r[1])); }
DI float xor32_max(float x) { unsigned u = __float_as_uint(x); auto r = __builtin_amdgcn_permlane32_swap(u, u, false, false); return fmaxf(__uint_as_float(r[0]), __uint_as_float(r[1])); }
DI float xor16_sum(float x) { unsigned u = __float_as_uint(x); auto r = __builtin_amdgcn_permlane16_swap(u, u, false, false); return __uint_as_float(r[0]) + __uint_as_float(r[1]); }
DI float xor32_sum(float x) { unsigned u = __float_as_uint(x); auto r = __builtin_amdgcn_permlane32_swap(u, u, false, false); return __uint_as_float(r[0]) + __uint_as_float(r[1]); }
DI s16x4 lds_tr4(const us* p) { return __builtin_amdgcn_ds_read_tr16_b64_v4i16((__attribute__((address_space(3))) s16x4*)p); }
DI float wave_sum(float v) {
#pragma unroll
  for (int o = 32; o >= 1; o >>= 1) v += __shfl_xor(v, o);
  return v;
}
typedef __bf16 bf2_t __attribute__((ext_vector_type(2)));
typedef float f2_t __attribute__((ext_vector_type(2)));
typedef unsigned u32x2 __attribute__((ext_vector_type(2)));
typedef unsigned u32x4 __attribute__((ext_vector_type(4)));
DI unsigned cvt2(float lo, float hi) { f2_t v = {lo, hi}; return __builtin_bit_cast(unsigned, __builtin_convertvector(v, bf2_t)); }
DI s16x4 pack4(float a, float b, float c, float d) { u32x2 r = {cvt2(a, b), cvt2(c, d)}; return __builtin_bit_cast(s16x4, r); }

#define XB_TMO      128
#define XB_XCNT(j)  (256  + 64 * (j))
#define XB_XSUB(j)  (1280 + 64 * (j))
#define XB_XGEN(j)  (2304 + 64 * (j))
#define XB_TOP      3328
#define XB_TOPGEN   3392
#define XCD_BAR_WORDS 3456
#define XB_SPIN_CAP (1u << 18)
#define LAS __attribute__((address_space(3)))

__device__ __forceinline__ unsigned xb_ld(unsigned* p)              { return __hip_atomic_load(p, __ATOMIC_RELAXED, __HIP_MEMORY_SCOPE_AGENT); }
__device__ __forceinline__ unsigned xb_add(unsigned* p, unsigned v) { return __hip_atomic_fetch_add(p, v, __ATOMIC_RELAXED, __HIP_MEMORY_SCOPE_AGENT); }
__device__ __forceinline__ unsigned xb_xcc_id() { return (unsigned)__builtin_amdgcn_s_getreg((3 << 11) | 20) & 0xFu; }
#define XB_SPIN(cond, bar) do { unsigned _sp = 0; while (cond) { __builtin_amdgcn_s_sleep(1); \
    if ((++_sp & 255u) == 0u) { if (xb_ld(&(bar)[XB_TMO])) break; if (_sp > XB_SPIN_CAP) { atomicAdd(&(bar)[XB_TMO], 1u); break; } } } } while (0)

struct XcdBarrier {
    unsigned* bar; unsigned x;
    volatile LAS unsigned* st;
};

__device__ __forceinline__ XcdBarrier xcd_barrier_post(unsigned* bar, volatile LAS unsigned* st) {
    XcdBarrier b; b.bar = bar; b.x = xb_xcc_id(); b.st = st;
    if (threadIdx.x == 0) (void)xb_add(&bar[XB_XCNT(b.x)], 1u);
    return b;
}
__device__ __forceinline__ void xcd_barrier_complete(unsigned* bar, unsigned x, unsigned& nloc, unsigned& nx) {
    const unsigned G = gridDim.x * gridDim.y * gridDim.z;
    unsigned sum, cnt, mine, sp = 0u;
    for (;;) {
        sum = 0u; cnt = 0u; mine = 0u;
#pragma unroll
        for (unsigned j = 0; j < 16; ++j) { const unsigned c = xb_ld(&bar[XB_XCNT(j)]); sum += c; cnt += (c > 0u) ? 1u : 0u; mine = (j == x) ? c : mine; }
        if (sum == G) break;
        __builtin_amdgcn_s_sleep(1);
        if ((++sp & 255u) == 0u) { if (xb_ld(&bar[XB_TMO])) break; if (sp > XB_SPIN_CAP) { atomicAdd(&bar[XB_TMO], 1u); break; } }
    }
    nloc = mine > 0u ? mine : 1u; nx = cnt > 0u ? cnt : 1u;
}

__device__ __forceinline__ void xcd_barrier(const XcdBarrier& b) {
    asm volatile("s_waitcnt vmcnt(0)" ::: "memory");
    __syncthreads();
    if (threadIdx.x == 0) {
        unsigned* bar = b.bar;
        __builtin_amdgcn_s_waitcnt(0);
        unsigned nloc = b.st[0], nx = b.st[1];
        if (nloc == 0u) { xcd_barrier_complete(bar, b.x, nloc, nx); b.st[0] = nloc; b.st[1] = nx; }
        const unsigned old = xb_add(&bar[XB_XSUB(b.x)], 1u);
        const unsigned gen = old / nloc;
        if (old + 1u == (gen + 1u) * nloc) {
            __builtin_amdgcn_fence(__ATOMIC_RELEASE, "agent");
            asm volatile("s_waitcnt vmcnt(0)" ::: "memory");
            const unsigned og = xb_add(&bar[XB_TOP], 1u);
            const unsigned tg = og / nx;
            if (og + 1u == (tg + 1u) * nx) xb_add(&bar[XB_TOPGEN], 1u);
            else XB_SPIN(xb_ld(&bar[XB_TOPGEN]) == tg, bar);
            __builtin_amdgcn_fence(__ATOMIC_ACQUIRE, "agent");
            xb_add(&bar[XB_XGEN(b.x)], 1u);
            asm volatile("s_waitcnt vmcnt(0)" ::: "memory");
        } else {
            XB_SPIN(xb_ld(&bar[XB_XGEN(b.x)]) == gen, bar);
            __builtin_amdgcn_fence(__ATOMIC_ACQUIRE, "agent");
            asm volatile("s_waitcnt vmcnt(0)" ::: "memory");
        }
    }
    __syncthreads();
}


namespace pg8 {
#define PG8_LAS __attribute__((address_space(3)))
typedef unsigned short bf16_t;
typedef short bf16x8 __attribute__((ext_vector_type(8)));
typedef float f32x4 __attribute__((ext_vector_type(4)));
typedef unsigned u32x4 __attribute__((ext_vector_type(4)));
constexpr int BM = 256, BK = 64, HALF = 128, HTB = HALF * BK * 2  , STAGE_BYTES = 8 * HTB, NXCD = 8, WGM = 8;

__host__ __device__ __forceinline__ int lds_byte(int r, int c) { const int st = (r >> 4) * 2 + (c >> 5), rr = r & 15, cc = c & 31, ob = rr * 64 + cc * 2; return st * 1024 + (ob ^ (((ob >> 9) & 1) << 5)); }
__host__ __device__ __forceinline__ void stage_rc(int b, int& R, int& C) { const int st = b / 1024, sb = b % 1024, swz = sb ^ (((sb >> 9) & 1) << 5); R = (st >> 1) * 16 + swz / 64; C = (st & 1) * 32 + (swz % 64) / 2; }
__host__ __device__ __forceinline__ int perm32(int rho) { const int n = rho >> 4, i = rho & 15; return 8 * (i >> 2) + 4 * n + (i & 3); }

struct Unit { int pm, pn; };
struct Gemm { const bf16_t* A; const bf16_t* Bt; int M, N, K; };

struct StaticOrder {
    int nM, nN, nwg, G, c;
    __host__ __device__ void init(int M, int N, int G_, int c_) { nM = M / BM; nN = N / BM; nwg = nM * nN; G = G_; c = c_; }
    __host__ __device__ bool next(int i, Unit& u) const {
        const long L = (long)i * G + c; if (L >= nwg) return false;
        int wgid = (int)L; { const int q = nwg / NXCD, r = nwg % NXCD, xcd = wgid % NXCD, off = wgid / NXCD; wgid = (xcd < r ? xcd * (q + 1) : r * (q + 1) + (xcd - r) * q) + off; }
        const int nig = WGM * nN, gid = wgid / nig, fm = gid * WGM, gsz = (nM - fm) < WGM ? (nM - fm) : WGM;
        u.pm = fm + ((wgid % nig) % gsz); u.pn = (wgid % nig) / gsz; return true;
    }
    __device__ __forceinline__ void a_ready(const Unit&) const {}
    __device__ __forceinline__ void done(const Unit&) const {}
};
template <class Epi, class Sched, bool STAMP = false>
__device__ __forceinline__ void gemm_phase(PG8_LAS unsigned char* lds, const Gemm g, const Sched& S, const Epi& E, unsigned long long* stamps) {
    const int tid = opaque_tid(), wid = __builtin_amdgcn_readfirstlane(tid >> 6), lane = tid & 63, wr = wid >> 2, wc = wid & 3, fr = lane & 15, fq = lane >> 4;
    const int K = g.K, nt = K / BK;
    int ts_lo = 0, ts_hi = 0, nts = 0; const unsigned long long rt_entry = STAMP ? (unsigned long long)wall_clock64() : 0ull;
#define PG8_STAMP() do { if (STAMP && wid == 0 && nts < 64) { const unsigned long long _c = (unsigned long long)clock64(); \
        ts_lo = (lane == nts) ? (int)(unsigned)_c : ts_lo; ts_hi = (lane == nts) ? (int)(unsigned)(_c >> 32) : ts_hi; ++nts; } } while (0)
    PG8_STAMP();
    unsigned voffA[2], voffB[2];
#pragma unroll
    for (int i = 0; i < 2; ++i) { int R, C; stage_rc(tid * 16 + i * 8192, R, C); const int Rb = Epi::PERM ? ((R & ~31) + perm32(R & 31)) : R;
        voffA[i] = (unsigned)(R * K + C) * 2u; voffB[i] = (unsigned)(Rb * K + C) * 2u; }
    const size_t kstep = (size_t)(BK * 2);
    const size_t hstep = (size_t)HALF * K * 2;
    const size_t tstep = 2 * hstep;
    const unsigned ldsw = (unsigned)wid * 1024u;
    const int aoff = lds_byte(wr * 64 + fr, fq * 8), boff = lds_byte(wc * 32 + fr, fq * 8);
#define PG8_SA(b, h) (((b) * 2 + (h)) * HTB)
#define PG8_SB(b, h) ((4 + (b) * 2 + (h)) * HTB)
#define PG8_STAGE(bufoff, gbase, voff) do { _Pragma("unroll") for (int _i = 0; _i < 2; ++_i) \
        __builtin_amdgcn_global_load_lds((const unsigned*)((const char*)(gbase) + (voff)[_i]), (PG8_LAS unsigned*)(lds + (bufoff) + ldsw + _i * 8192), 16, 0, 0); } while (0)
#define PG8_LDA(dst, b, h) do { _Pragma("unroll") for (int m = 0; m < 4; ++m) _Pragma("unroll") for (int k = 0; k < 2; ++k) dst[m][k] = *(const PG8_LAS bf16x8*)(lds + PG8_SA(b, h) + aoff + m * 2048 + k * 1024); } while (0)
#define PG8_LDB(dst, b, h) do { _Pragma("unroll") for (int n = 0; n < 2; ++n) _Pragma("unroll") for (int k = 0; k < 2; ++k) dst[n][k] = *(const PG8_LAS bf16x8*)(lds + PG8_SB(b, h) + boff + n * 2048 + k * 1024); } while (0)
#define PG8_MMA(ai, bj, At, Bt) do { __builtin_amdgcn_s_setprio(1); _Pragma("unroll") for (int m = 0; m < 4; ++m) _Pragma("unroll") for (int n = 0; n < 2; ++n) _Pragma("unroll") for (int k = 0; k < 2; ++k) \
        acc[ai][bj][m][n] = __builtin_amdgcn_mfma_f32_16x16x32_bf16(Bt[n][k], At[m][k], acc[ai][bj][m][n], 0, 0, 0); __builtin_amdgcn_s_setprio(0); } while (0)
#define PG8_WAIT_V(n) asm volatile("s_waitcnt vmcnt(" #n ")" ::: "memory")
#define PG8_WAIT_L(n) asm volatile("s_waitcnt lgkmcnt(" #n ")" ::: "memory")
#define PG8_BAR __builtin_amdgcn_s_barrier()
#define PG8_SCHED __builtin_amdgcn_sched_barrier(0)
    Unit cur, nxt; int ui = 0;
    if (!S.next(0, cur)) return;
    f32x4 acc[2][2][4][2];
#pragma unroll
    for (int a = 0; a < 2; ++a)
#pragma unroll
        for (int b = 0; b < 2; ++b)
#pragma unroll
            for (int m = 0; m < 4; ++m)
#pragma unroll
                for (int n = 0; n < 2; ++n) acc[a][b][m][n] = (f32x4){0.f, 0.f, 0.f, 0.f};
    bf16x8 At[4][2], B0[2][2], B1[2][2];
    const char* cA = (const char*)g.A + (size_t)cur.pm * tstep; const char* cB = (const char*)g.Bt + (size_t)cur.pn * tstep;
    S.a_ready(cur);
    PG8_STAGE(PG8_SB(0, 0), cB, voffB); PG8_STAGE(PG8_SA(0, 0), cA, voffA); PG8_STAGE(PG8_SB(0, 1), cB + hstep, voffB); PG8_STAGE(PG8_SA(0, 1), cA + hstep, voffA);
    if (wr == 1) PG8_BAR;
    PG8_WAIT_V(4); PG8_BAR;
    PG8_STAGE(PG8_SB(1, 0), cB + kstep, voffB); PG8_STAGE(PG8_SA(1, 0), cA + kstep, voffA); PG8_STAGE(PG8_SB(1, 1), cB + hstep + kstep, voffB);
    PG8_WAIT_V(6); PG8_BAR;
    PG8_STAMP();
    for (;;) {
        const bool has_next = S.next(ui + 1, nxt);
        const char* nA = has_next ? (const char*)g.A + (size_t)nxt.pm * tstep : cA; const char* nB = has_next ? (const char*)g.Bt + (size_t)nxt.pn * tstep : cB;
        for (int t = 0; t < nt; t += 2) {
            const bool last = (t == nt - 2);
            const char* a1 = cA + (size_t)(t + 1) * kstep;
            const char* a2 = last ? nA : cA + (size_t)(t + 2) * kstep; const char* b2 = last ? nB : cB + (size_t)(t + 2) * kstep;
            const char* a3 = a2 + kstep; const char* b3 = b2 + kstep;
            if (last && has_next) S.a_ready(nxt);
            PG8_LDB(B0, 0, 0); PG8_SCHED; PG8_LDA(At, 0, 0); PG8_STAGE(PG8_SA(1, 1), a1 + hstep, voffA);
            PG8_WAIT_L(8); PG8_BAR; PG8_WAIT_L(0); PG8_MMA(0, 0, At, B0); PG8_BAR; PG8_SCHED;
            PG8_LDB(B1, 0, 1); PG8_STAGE(PG8_SB(0, 0), b2, voffB);
            PG8_BAR; PG8_WAIT_L(0); PG8_MMA(0, 1, At, B1); PG8_BAR;
            PG8_LDA(At, 0, 1); PG8_STAGE(PG8_SA(0, 0), a2, voffA);
            PG8_BAR; PG8_WAIT_L(0); PG8_MMA(1, 0, At, B0); PG8_BAR; PG8_SCHED;
            PG8_STAGE(PG8_SB(0, 1), b2 + hstep, voffB);
            PG8_WAIT_V(6); PG8_BAR; PG8_MMA(1, 1, At, B1); PG8_BAR;
            PG8_LDB(B0, 1, 0); PG8_SCHED; PG8_LDA(At, 1, 0); PG8_STAGE(PG8_SA(0, 1), a2 + hstep, voffA);
            PG8_WAIT_L(8); PG8_BAR; PG8_WAIT_L(0); PG8_MMA(0, 0, At, B0); PG8_BAR; PG8_SCHED;
            PG8_LDB(B1, 1, 1); PG8_STAGE(PG8_SB(1, 0), b3, voffB);
            PG8_BAR; PG8_WAIT_L(0); PG8_MMA(0, 1, At, B1); PG8_BAR;
            PG8_LDA(At, 1, 1); PG8_STAGE(PG8_SA(1, 0), a3, voffA);
            PG8_BAR; PG8_WAIT_L(0); PG8_MMA(1, 0, At, B0); PG8_BAR; PG8_SCHED;
            PG8_STAGE(PG8_SB(1, 1), b3 + hstep, voffB);
            PG8_WAIT_V(6); PG8_BAR; PG8_MMA(1, 1, At, B1); PG8_BAR;
        }
        PG8_STAMP();
        if constexpr (!Epi::AFTER_DRAIN) { E(acc, cur, wr, wc, fr, fq); S.done(cur); }
        PG8_STAMP();
        if (!has_next) break;
#pragma unroll
        for (int a = 0; a < 2; ++a)
#pragma unroll
            for (int b = 0; b < 2; ++b)
#pragma unroll
                for (int m = 0; m < 4; ++m)
#pragma unroll
                    for (int n = 0; n < 2; ++n) acc[a][b][m][n] = (f32x4){0.f, 0.f, 0.f, 0.f};
        cur = nxt; cA = nA; cB = nB; ++ui;
    }
    PG8_WAIT_V(0);
    if (wr == 0) PG8_BAR;
    PG8_BAR;
    if constexpr (Epi::AFTER_DRAIN) { E.fused(acc, cur, wr, wc, fr, fq, lds, wid, lane); S.done(cur); }
    PG8_STAMP();
    if (STAMP && wid == 0) { stamps[lane] = lane < nts ? (((unsigned long long)(unsigned)ts_hi << 32) | (unsigned)ts_lo) : 0ull;
        if (lane == 62) stamps[62] = rt_entry; if (lane == 63) stamps[63] = (unsigned long long)wall_clock64(); }
#undef PG8_STAMP
#undef PG8_SA
#undef PG8_SB
#undef PG8_STAGE
#undef PG8_LDA
#undef PG8_LDB
#undef PG8_MMA
#undef PG8_WAIT_V
#undef PG8_WAIT_L
#undef PG8_BAR
#undef PG8_SCHED
}
}

struct EpiB16 {
  static constexpr bool PERM = true, AFTER_DRAIN = false;
  us* O; int ldc; int ACT;
  DI void operator()(const f32x4 (&acc)[2][2][4][2], const pg8::Unit& u, int wr, int wc, int fr, int fq) const {
    const int row0 = u.pm * 256 + wr * 64 + fr, col0 = u.pn * 256 + wc * 32 + 8 * fq;
#pragma unroll
    for (int ai = 0; ai < 2; ++ai)
#pragma unroll
      for (int m = 0; m < 4; ++m) {
        us* rowp = O + (size_t)(row0 + ai * 128 + m * 16) * ldc + col0;
#pragma unroll
        for (int bj = 0; bj < 2; ++bj) {
          f32x4 v0 = acc[ai][bj][m][0], v1 = acc[ai][bj][m][1];
          if (ACT == 1) {
#pragma unroll
            for (int j = 0; j < 4; ++j) { float a = fmaxf(v0[j], 0.f), b = fmaxf(v1[j], 0.f); v0[j] = a * a; v1[j] = b * b; }
          }
          u32x4 w = {cvt2(v0[0], v0[1]), cvt2(v0[2], v0[3]), cvt2(v1[0], v1[1]), cvt2(v1[2], v1[3])};
          *(u32x4*)(rowp + bj * 128) = w;
        }
      }
  }
};

struct ALoadCmp {
  const us* base;
  const float* pe;
  int r0;
  DI bf16x8 operator()(int r, int kt, int kc) const {
    int n = r + r0; n = n < 126 ? n : 126;
    bf16x8 v = *(const bf16x8*)(base + (size_t)(16 * n + kt) * LDP + kc * 8);
    const float* pp = pe + kt * 64 + kc * 8;
    bf16x8 o;
#pragma unroll
    for (int e = 0; e < 8; ++e) o[e] = (short)f2bf(bf2f((us)v[e]) + pp[e]);
    return o;
  }
};

template <int MW, class AL, class EPI>
DI void gemm_tile(const AL& al, const us* __restrict__ Bt, int ldb, int n0, int nk  , const EPI& epi, char* smem) {
  constexpr int BM = MW * 64, NW = 8 / MW, NT = 128 / NW / 16, AI = BM * 8 / 512, STG = (BM + 128) * 80;
  us(*As)[80] = (us(*)[80])smem;
  us(*Bs)[80] = (us(*)[80])(smem + BM * 80 * 2);
  const int tid = opaque_tid(), lane = tid & 63, wid = tid >> 6, wr = wid / NW, wc = wid % NW, fr = lane & 15, fq = lane >> 4;
  f32x4 acc[4][NT];
#pragma unroll
  for (int m = 0; m < 4; ++m)
#pragma unroll
    for (int n = 0; n < NT; ++n) acc[m][n] = f32x4{0.f, 0.f, 0.f, 0.f};
  bf16x8 ra0[AI], rb0[2], ra1[AI], rb1[2];
#define GT_LOAD(RA, RB, KT) do { \
    _Pragma("unroll") for (int i = 0; i < AI; ++i) { int c = tid + 512 * i, r = c >> 3, kc = c & 7; RA[i] = al(r, (KT), kc); } \
    _Pragma("unroll") for (int i = 0; i < 2; ++i) { int c = tid + 512 * i, r = c >> 3, kc = c & 7; RB[i] = *(const bf16x8*)(Bt + (size_t)(n0 + r) * ldb + (KT) * 64 + kc * 8); } } while (0)
#define GT_STORE(RA, RB, S) do { \
    _Pragma("unroll") for (int i = 0; i < AI; ++i) { int c = tid + 512 * i, r = c >> 3, kc = c & 7; *(bf16x8*)&As[(S) * (BM + 128) + r][kc * 8] = RA[i]; } \
    _Pragma("unroll") for (int i = 0; i < 2; ++i) { int c = tid + 512 * i, r = c >> 3, kc = c & 7; *(bf16x8*)&Bs[(S) * (BM + 128) + r][kc * 8] = RB[i]; } } while (0)
#define GT_COMPUTE(S) do { \
    _Pragma("unroll") for (int ks = 0; ks < 2; ++ks) { \
      bf16x8 af[4], bfr[NT]; \
      _Pragma("unroll") for (int m = 0; m < 4; ++m) af[m] = *(const bf16x8*)&As[(S) * (BM + 128) + wr * 64 + m * 16 + fr][ks * 32 + fq * 8]; \
      _Pragma("unroll") for (int n = 0; n < NT; ++n) bfr[n] = *(const bf16x8*)&Bs[(S) * (BM + 128) + wc * (NT * 16) + n * 16 + fr][ks * 32 + fq * 8]; \
      _Pragma("unroll") for (int m = 0; m < 4; ++m) _Pragma("unroll") for (int n = 0; n < NT; ++n) acc[m][n] = MFMA16(bfr[n], af[m], acc[m][n]); } } while (0)
  GT_LOAD(ra0, rb0, 0);
  GT_LOAD(ra1, rb1, 1);
  __syncthreads();
  GT_STORE(ra0, rb0, 0);
  __syncthreads();
  for (int kt = 0; kt < nk; kt += 2) {
    if (kt + 2 < nk) GT_LOAD(ra0, rb0, kt + 2);
    GT_COMPUTE(0);
    GT_STORE(ra1, rb1, 1);
    __syncthreads();
    if (kt + 3 < nk) GT_LOAD(ra1, rb1, kt + 3);
    GT_COMPUTE(1);
    if (kt + 2 < nk) GT_STORE(ra0, rb0, 0);
    __syncthreads();
  }
#undef GT_LOAD
#undef GT_STORE
#undef GT_COMPUTE
#pragma unroll
  for (int m = 0; m < 4; ++m)
#pragma unroll
    for (int n = 0; n < NT; ++n) epi(wr * 64 + m * 16 + fr, wc * (NT * 16) + n * 16 + fq * 4, acc[m][n]);
}

struct EpiGeluLds {
  us* Hs;
  DI void operator()(int r, int c, f32x4 v) const {
    float o[4];
#pragma unroll
    for (int j = 0; j < 4; ++j) {
      float xx = v[j];
      float t = tanhf(0.7978845608028654f * (xx + 0.044715f * xx * xx * xx));
      o[j] = 0.5f * xx * (1.f + t);
    }
    *(s16x4*)(Hs + r * 136 + c) = pack4(o[0], o[1], o[2], o[3]);
  }
};

DI int remap_win(int n) { return n < 1280 ? n : (n < 1304 ? n + 768 : n - 24); }

DI void transpose_wave(const float* __restrict__ src, int K, int N, us* __restrict__ dst, int kt, int nt, bool remap, int lane) {
  const int n = nt * 64 + lane;
  const bool ok = n < N;
  const float* sp = src + (size_t)(kt * 64) * N + (ok ? n : 0);
  float v[64];
#pragma unroll
  for (int k = 0; k < 64; ++k) v[k] = __builtin_nontemporal_load(sp + (size_t)k * N);
  if (ok) {
    const int nn = remap ? remap_win(n) : n;
    u32x4* dp = (u32x4*)(dst + (size_t)nn * K + kt * 64);
#pragma unroll
    for (int q = 0; q < 8; ++q) {
      u32x4 w = {cvt2(v[8 * q], v[8 * q + 1]), cvt2(v[8 * q + 2], v[8 * q + 3]), cvt2(v[8 * q + 4], v[8 * q + 5]), cvt2(v[8 * q + 6], v[8 * q + 7])};
      dp[q] = w;
    }
  }
}

DI void phase0(const Params& p, char* smem) {
  const int tid = opaque_tid(), lane = tid & 63, wid = tid >> 6;
  const int gw = blockIdx.x * 8 + wid, nw = gridDim.x * 8;
  for (int it = gw; it < 792; it += nw) {
    int i = it;
    if (i < 528) { transpose_wave(p.w_in, 1024, 2072, p.wt_in, i / 33, i % 33, true, lane); continue; }
    i -= 528;
    if (i < 128) { transpose_wave(p.w1_k, 2048, 256, p.w1t_k, i / 4, i % 4, false, lane); continue; }
    i -= 128;
    if (i < 128) { transpose_wave(p.w1_v, 2048, 256, p.w1t_v, i / 4, i % 4, false, lane); continue; }
    i -= 128;
    if (i < 4) { transpose_wave(p.w2_k, 256, 64, p.w2t_k, i, 0, false, lane); continue; }
    i -= 4;
    transpose_wave(p.w2_v, 256, 64, p.w2t_v, i, 0, false, lane);
  }
  {
    unsigned* z = (unsigned*)(p.wt_in + (size_t)2072 * 1024);
    for (int i = blockIdx.x * 512 + tid; i < 104 * 512; i += gridDim.x * 512) z[i] = 0u;
    float* kz = p.kcf;
    for (int i = blockIdx.x * 512 + tid; i < 2 * 32 * 128 * 64; i += gridDim.x * 512) kz[i] = 0.f;
  }
  for (int row = gw * 2; row < NTOK; row += nw * 2) {
    float4 v[2][4];
#pragma unroll
    for (int r = 0; r < 2; ++r)
#pragma unroll
      for (int i = 0; i < 4; ++i) { f32x4 t = __builtin_nontemporal_load(((const f32x4*)(p.x + (size_t)(row + r) * 1024)) + lane + 64 * i); v[r][i] = float4{t[0], t[1], t[2], t[3]}; }
    float4 g[4];
#pragma unroll
    for (int i = 0; i < 4; ++i) g[i] = ((const float4*)p.g_mix_pre)[lane + 64 * i];
#pragma unroll
    for (int r = 0; r < 2; ++r) {
      float ss = 0.f;
#pragma unroll
      for (int i = 0; i < 4; ++i) ss += v[r][i].x * v[r][i].x + v[r][i].y * v[r][i].y + v[r][i].z * v[r][i].z + v[r][i].w * v[r][i].w;
      ss = wave_sum(ss);
      const float rs = rsqrtf(ss * (1.f / 1024.f) + EPS);
#pragma unroll
      for (int i = 0; i < 4; ++i)
        *(s16x4*)(p.a + (size_t)(row + r) * 1024 + (lane + 64 * i) * 4) =
            pack4(v[r][i].x * rs * g[i].x, v[r][i].y * rs * g[i].y, v[r][i].z * rs * g[i].z, v[r][i].w * rs * g[i].w);
    }
  }
}

DI void attn_tile64(const us (*Ks)[80], const us (*Vt)[80], const bf16x8 (&qf)[2][2], f32x4 (&o)[4][2], float (&M)[2], float (&l)[2],
                    const float (&sl2)[2], const float (&qs)[2], const f32x4 (&idxf)[4], int key0, int tok, int fr, int fq,
                    int mode, int window, bool sel) {
  bf16x8 kf[4][2];
#pragma unroll
  for (int mt = 0; mt < 4; ++mt)
#pragma unroll
    for (int ks = 0; ks < 2; ++ks) kf[mt][ks] = *(const bf16x8*)&Ks[mt * 16 + fr][ks * 32 + fq * 8];
  bf16x8 vf[4][2];
#pragma unroll
  for (int dt = 0; dt < 4; ++dt)
#pragma unroll
    for (int s2 = 0; s2 < 2; ++s2) {
      s16x4 lo = lds_tr4(&Vt[s2 * 32 + fq * 4 + (fr >> 2)][dt * 16 + (fr & 3) * 4]);
      s16x4 hi = lds_tr4(&Vt[s2 * 32 + 16 + fq * 4 + (fr >> 2)][dt * 16 + (fr & 3) * 4]);
      vf[dt][s2] = __builtin_shufflevector(lo, hi, 0, 1, 2, 3, 4, 5, 6, 7);
    }
  const float Df = (float)(tok - key0);
  const float thr = (mode == 2) ? Df - (float)window : Df;
#pragma unroll
  for (int nt = 0; nt < 2; ++nt) {
    const bf16x8 q0 = nt ? qf[1][0] : qf[0][0];
    const bf16x8 q1 = nt ? qf[1][1] : qf[0][1];
    const float sl = nt ? sl2[1] : sl2[0];
    const float qsn = nt ? qs[1] : qs[0];
    const float Mold = nt ? M[1] : M[0];
    f32x4 s[4];
    __builtin_amdgcn_s_setprio(1);
#pragma unroll
    for (int mt = 0; mt < 4; ++mt) {
      s[mt] = f32x4{0.f, 0.f, 0.f, 0.f};
      s[mt] = MFMA16(kf[mt][0], q0, s[mt]);
      s[mt] = MFMA16(kf[mt][1], q1, s[mt]);
    }
    __builtin_amdgcn_s_setprio(0);
#pragma unroll
    for (int mt = 0; mt < 4; ++mt) s[mt] = s[mt] * qsn + idxf[mt];
    if (mode == 1) {
#pragma unroll
      for (int mt = 0; mt < 4; ++mt)
#pragma unroll
        for (int j = 0; j < 4; ++j) s[mt][j] = (idxf[mt][j] <= thr) ? s[mt][j] : NEG_INF;
    } else if (mode == 2) {
#pragma unroll
      for (int mt = 0; mt < 4; ++mt)
#pragma unroll
        for (int j = 0; j < 4; ++j) s[mt][j] = (idxf[mt][j] > thr) ? s[mt][j] : NEG_INF;
    }
    float mx = fmaxf(fmaxf(s[0][0], s[0][1]), fmaxf(s[0][2], s[0][3]));
#pragma unroll
    for (int mt = 1; mt < 4; ++mt) mx = fmaxf(fmaxf(mx, s[mt][0]), fmaxf(fmaxf(s[mt][1], s[mt][2]), s[mt][3]));
    mx = xor16_max(mx);
    mx = xor32_max(mx);
    mx = sel ? mx - Df : NEG_INF;
    const float Mnew = fmaxf(Mold, mx);
    const float Muse = (Mnew == NEG_INF) ? 0.f : Mnew;
    const float alpha = ex2(sl * (Mold - Muse));
    const float c = sel ? -sl * (Df + Muse) : NEG_INF;
    float ps = 0.f;
#pragma unroll
    for (int mt = 0; mt < 4; ++mt) {
      s[mt] = s[mt] * sl + c;
#pragma unroll
      for (int j = 0; j < 4; ++j) s[mt][j] = ex2(s[mt][j]);
    }
    {
      f32x4 t = (s[0] + s[1]) + (s[2] + s[3]);
      ps = (t[0] + t[1]) + (t[2] + t[3]);
    }
    bf16x8 pb[2];
#pragma unroll
    for (int s2 = 0; s2 < 2; ++s2) {
      s16x4 lo = pack4(s[2 * s2][0], s[2 * s2][1], s[2 * s2][2], s[2 * s2][3]);
      s16x4 hi = pack4(s[2 * s2 + 1][0], s[2 * s2 + 1][1], s[2 * s2 + 1][2], s[2 * s2 + 1][3]);
      pb[s2] = __builtin_shufflevector(lo, hi, 0, 1, 2, 3, 4, 5, 6, 7);
    }
    const bool resc = __ballot(alpha != 1.f) != 0ull;
    if (nt == 0) {
      M[0] = Mnew; l[0] = l[0] * alpha + ps;
      if (resc) {
#pragma unroll
        for (int dt = 0; dt < 4; ++dt) o[dt][0] *= alpha;
      }
      __builtin_amdgcn_s_setprio(1);
#pragma unroll
      for (int dt = 0; dt < 4; ++dt)
#pragma unroll
        for (int s2 = 0; s2 < 2; ++s2) o[dt][0] = MFMA16(vf[dt][s2], pb[s2], o[dt][0]);
      __builtin_amdgcn_s_setprio(0);
    } else {
      M[1] = Mnew; l[1] = l[1] * alpha + ps;
      if (resc) {
#pragma unroll
        for (int dt = 0; dt < 4; ++dt) o[dt][1] *= alpha;
      }
      __builtin_amdgcn_s_setprio(1);
#pragma unroll
      for (int dt = 0; dt < 4; ++dt)
#pragma unroll
        for (int s2 = 0; s2 < 2; ++s2) o[dt][1] = MFMA16(vf[dt][s2], pb[s2], o[dt][1]);
      __builtin_amdgcn_s_setprio(0);
    }
  }
}

DI void load_kv64(const us* __restrict__ projb, int key0, int kcol, int vcol, int tid, bf16x8& kr, bf16x8& vr) {
  const us* rp = projb + (size_t)(key0 + (tid >> 3)) * LDP + (tid & 7) * 8;
  kr = *(const bf16x8*)(rp + kcol);
  vr = *(const bf16x8*)(rp + vcol);
}
DI void store_kv64(us (*Ks)[80], us (*Vt)[80], int tid, const bf16x8& kr, const bf16x8& vr) {
  *(bf16x8*)&Ks[tid >> 3][(tid & 7) * 8] = kr;
  *(bf16x8*)&Vt[tid >> 3][(tid & 7) * 8] = vr;
}

DI void banded_item(const Params& p, int b, int g, int tq, int kind, char* smem) {
  us(*Ks)[80] = (us(*)[80])smem;
  us(*Vt)[80] = (us(*)[80])(smem + 2 * 64 * 80 * 2);
  const int tid = opaque_tid(), lane = tid & 63, w = tid >> 6, fr = lane & 15, fq = lane >> 4;
  const int tg = w >> 1, hp = w & 1;
  const int t0 = tq * 64, tok = t0 + 16 * tg + fr;
  const int qcol = kind ? C_QS : C_QN, kcol = (kind ? C_KSW : C_KW) + g * 64, vcol = (kind ? C_VSW : C_VW) + g * 64;
  const int window = kind ? 128 : 512;
  const us* projb = p.proj + (size_t)b * T * LDP;
  bf16x8 qf[2][2];
  f32x4 o[4][2];
  float m[2], l[2], slope2[2], qs[2];
  f32x4 idxf[4];
#pragma unroll
  for (int mt = 0; mt < 4; ++mt)
#pragma unroll
    for (int j = 0; j < 4; ++j) idxf[mt][j] = (float)(mt * 16 + fq * 4 + j);
#pragma unroll
  for (int r = 0; r < 2; ++r) {
    int hh = g * 4 + hp * 2 + r;
#pragma unroll
    for (int ks = 0; ks < 2; ++ks) qf[r][ks] = __builtin_nontemporal_load((const bf16x8*)(projb + (size_t)tok * LDP + qcol + hh * 64 + ks * 32 + fq * 8));
    float sl = kind ? exp2f(-(float)(hh + 1)) : exp2f(-0.5f * (float)(2 * hh + 1));
    slope2[r] = sl * LOG2E;
    qs[r] = SC2 / slope2[r];
    if (kind) { m[r] = p.sinks[hh] * LOG2E / slope2[r]; l[r] = (fq == 0) ? 1.f : 0.f; }
    else { m[r] = NEG_INF; l[r] = 0.f; }
#pragma unroll
    for (int dt = 0; dt < 4; ++dt) o[dt][r] = f32x4{0.f, 0.f, 0.f, 0.f};
  }
  int kt0 = t0 - window; if (kt0 < 0) kt0 = 0; kt0 >>= 6;
  {
    bf16x8 kr, vr;
    load_kv64(projb, tq * 64, kcol, vcol, tid, kr, vr);
    __syncthreads();
    store_kv64(Ks, Vt, tid, kr, vr);
    __syncthreads();
    int cur = 0;
    for (int kt = tq; kt >= kt0; --kt) {
      const bool more = kt > kt0;
      if (more) load_kv64(projb, (kt - 1) * 64, kcol, vcol, tid, kr, vr);
      const int mode = (kt == tq) ? 1 : ((64 * (tq - kt) + 63 >= window) ? 2 : 0);
      attn_tile64(Ks + cur * 64, Vt + cur * 64, qf, o, m, l, slope2, qs, idxf, kt * 64, tok, fr, fq, mode, window, true);
      if (more) store_kv64(Ks + (cur ^ 1) * 64, Vt + (cur ^ 1) * 64, tid, kr, vr);
      __syncthreads();
      cur ^= 1;
    }
  }
  const size_t rowg = (size_t)b * T + tok;
#pragma unroll
  for (int r = 0; r < 2; ++r) {
    float lt = l[r]; lt = xor16_sum(lt); lt = xor32_sum(lt);
    float inv = lt > 0.f ? 1.f / lt : 0.f;
    int hh = g * 4 + hp * 2 + r;
    if (!kind) inv *= p.gates[rowg * 24 + hh * 3 + 2];
    us* dst = p.attn + rowg * 1024 + (kind ? 512 : 0) + hh * 64 + fq * 4;
#pragma unroll
    for (int dt = 0; dt < 4; ++dt) *(s16x4*)(dst + dt * 16) = pack4(o[dt][r][0] * inv, o[dt][r][1] * inv, o[dt][r][2] * inv, o[dt][r][3] * inv);
  }
}

DI void compress_item(const Params& p, int item, char* smem) {
  const int mh = item & 1, nh = (item >> 1) & 1, g = (item >> 2) & 1, b = (item >> 3) & 15, kv = item >> 7;
  const us* base = p.proj + (size_t)b * T * LDP + (kv ? C_VC : C_KC) + g * 64;
  ALoadCmp al{base, kv ? p.pe_v : p.pe_k, mh * 64};
  const us* w1t = kv ? p.w1t_v : p.w1t_k;
  const us* w2t = kv ? p.w2t_v : p.w2t_k;
  float* dst = (kv ? p.vcf : p.kcf) + (size_t)(b * 2 + g) * 128 * 64 + (size_t)mh * 64 * 64;
  us* Hs = (us*)smem;
  us* Ws = (us*)(smem + 64 * 136 * 2);
  const int tid = opaque_tid(), lane = tid & 63, w = tid >> 6, fr = lane & 15, fq = lane >> 4;
  EpiGeluLds epi{Hs};
  gemm_tile<1>(al, w1t, 2048, nh * 128, 32, epi, smem);
#pragma unroll
  for (int i = 0; i < 2; ++i) {
    int c = tid + 512 * i, r = c >> 4, ch = c & 15;
    *(bf16x8*)(Ws + r * 136 + ch * 8) = *(const bf16x8*)(w2t + (size_t)r * 256 + nh * 128 + ch * 8);
  }
  __syncthreads();
  const int mrow = (w & 3) * 16, n0 = (w >> 2) * 2;
  f32x4 acc[2];
#pragma unroll
  for (int n = 0; n < 2; ++n) acc[n] = f32x4{0.f, 0.f, 0.f, 0.f};
#pragma unroll
  for (int ks = 0; ks < 4; ++ks) {
    bf16x8 af = *(const bf16x8*)(Hs + (mrow + fr) * 136 + ks * 32 + fq * 8);
#pragma unroll
    for (int n = 0; n < 2; ++n) {
      bf16x8 bfr = *(const bf16x8*)(Ws + ((n0 + n) * 16 + fr) * 136 + ks * 32 + fq * 8);
      acc[n] = MFMA16(bfr, af, acc[n]);
    }
  }
#pragma unroll
  for (int n = 0; n < 2; ++n) {
    float* d = dst + (size_t)(mrow + fr) * 64 + (n0 + n) * 16 + fq * 4;
#pragma unroll
    for (int j = 0; j < 4; ++j) atomicAdd(d + j, acc[n][j]);
  }
  __syncthreads();
}

DI void cmp_probs(const us* KcS, const bf16x8 (&qfn)[2], float slope2, int tok, int fr, int fq, int npair, f32x4 (&s)[8]) {
  float mx = NEG_INF;
#pragma unroll
  for (int pr = 0; pr < 4; ++pr) {
    if (pr < npair) {
#pragma unroll
      for (int h = 0; h < 2; ++h) {
        const int mt = pr * 2 + h;
        s[mt] = f32x4{0.f, 0.f, 0.f, 0.f};
#pragma unroll
        for (int ks = 0; ks < 2; ++ks) {
          bf16x8 kf = *(const bf16x8*)(KcS + (mt * 16 + fr) * 80 + ks * 32 + fq * 8);
          s[mt] = MFMA16(kf, qfn[ks], s[mt]);
        }
      }
#pragma unroll
      for (int h = 0; h < 2; ++h) {
        const int mt = pr * 2 + h;
#pragma unroll
        for (int j = 0; j < 4; ++j) {
          int n = mt * 16 + fq * 4 + j;
          int dist = tok - (16 * n + 31);
          float v = dist >= 0 ? (s[mt][j] * SC2 - slope2 * (float)dist) : NEG_INF;
          s[mt][j] = v;
          mx = fmaxf(mx, v);
        }
      }
    }
  }
  mx = xor16_max(mx);
  mx = xor32_max(mx);
  float muse = (mx == NEG_INF) ? 0.f : mx;
  float ps = 0.f;
#pragma unroll
  for (int pr = 0; pr < 4; ++pr) {
    if (pr < npair) {
#pragma unroll
      for (int h = 0; h < 2; ++h)
#pragma unroll
        for (int j = 0; j < 4; ++j) { float pv = ex2(s[pr * 2 + h][j] - muse); s[pr * 2 + h][j] = pv; ps += pv; }
    } else {
      s[pr * 2] = f32x4{0.f, 0.f, 0.f, 0.f}; s[pr * 2 + 1] = f32x4{0.f, 0.f, 0.f, 0.f};
    }
  }
  ps = xor16_sum(ps);
  ps = xor32_sum(ps);
  float inv = ps > 0.f ? 1.f / ps : 0.f;
#pragma unroll
  for (int mt = 0; mt < 8; ++mt) s[mt] *= inv;
}

DI void nsa_item(const Params& p, int b, int g, int tq, char* smem) {
  us* KcS = (us*)smem;
  us* VcT = (us*)(smem + 20480);
  us(*Ks)[80] = (us(*)[80])(smem + 40960);
  us(*Vt)[80] = (us(*)[80])(smem + 61440);
  float* impS = (float*)(smem + 81920);
  float* impL = (float*)(smem + 98816);
  unsigned* unionS = (unsigned*)(smem + 115712);
  u32x4* ocS = (u32x4*)smem;
  const int tid = opaque_tid(), lane = tid & 63, w = tid >> 6, fr = lane & 15, fq = lane >> 4;
  const int tg = w >> 1, hp = w & 1;
  const int t0 = tq * 64, tok = t0 + 16 * tg + fr;
  const us* projb = p.proj + (size_t)b * T * LDP;
  const float* kcf = p.kcf + (size_t)(b * 2 + g) * 128 * 64;
  const float* vcf = p.vcf + (size_t)(b * 2 + g) * 128 * 64;
  const size_t rowg = (size_t)b * T + tok;
  int npair = ((tq * 4 + 2) >> 5) + 1; if (npair > 4) npair = 4;
  const int nrows = npair * 32;
  __syncthreads();
#pragma unroll
  for (int i = 0; i < 2; ++i) {
    int c = tid + 512 * i, r = c >> 3, ch = c & 7;
    if (r >= nrows) continue;
    const float4* s4 = (const float4*)(kcf + r * 64 + ch * 8);
    float4 a0 = s4[0], a1 = s4[1];
    s16x4 lo = pack4(a0.x, a0.y, a0.z, a0.w), hi = pack4(a1.x, a1.y, a1.z, a1.w);
    *(bf16x8*)(KcS + r * 80 + ch * 8) = __builtin_shufflevector(lo, hi, 0, 1, 2, 3, 4, 5, 6, 7);
  }
#pragma unroll
  for (int i = 0; i < 2; ++i) {
    int c = tid + 512 * i, r = c >> 3, ch = c & 7;
    if (r >= nrows) continue;
    const float4* s4 = (const float4*)(vcf + r * 64 + ch * 8);
    float4 a0 = s4[0], a1 = s4[1];
    s16x4 lo = pack4(a0.x, a0.y, a0.z, a0.w), hi = pack4(a1.x, a1.y, a1.z, a1.w);
    *(bf16x8*)(VcT + r * 80 + ch * 8) = __builtin_shufflevector(lo, hi, 0, 1, 2, 3, 4, 5, 6, 7);
  }
  if (tid == 0) *unionS = 0u;
  bf16x8 qf[2][2];
  float slope2[2];
#pragma unroll
  for (int r = 0; r < 2; ++r) {
    int hh = g * 4 + hp * 2 + r;
#pragma unroll
    for (int ks = 0; ks < 2; ++ks) qf[r][ks] = __builtin_nontemporal_load((const bf16x8*)(projb + (size_t)tok * LDP + C_QN + hh * 64 + ks * 32 + fq * 8));
    slope2[r] = exp2f(-0.5f * (float)(2 * hh + 1)) * LOG2E;
  }
  __syncthreads();
  u32x4 ocp[4];
  {
    float accA[8], accL[8];
#pragma unroll
    for (int mt = 0; mt < 8; ++mt) { accA[mt] = 0.f; accL[mt] = 0.f; }
#pragma unroll 1
    for (int nt = 0; nt < 2; ++nt) {
      bf16x8 qn[2];
      qn[0] = nt ? qf[1][0] : qf[0][0];
      qn[1] = nt ? qf[1][1] : qf[0][1];
      f32x4 s[8];
      int frz = fr, fqz = fq, tokz = tok;
      asm volatile("" : "+v"(frz), "+v"(fqz), "+v"(tokz));
      cmp_probs(KcS, qn, nt ? slope2[1] : slope2[0], tokz, frz, fqz, npair, s);
#pragma unroll
      for (int mt = 0; mt < 8; ++mt) {
        accA[mt] += (s[mt][0] + s[mt][1]) + (s[mt][2] + s[mt][3]);
        accL[mt] += s[mt][3];
      }
      const float g0 = p.gates[rowg * 24 + (g * 4 + hp * 2 + nt) * 3 + 0];
      f32x4 tmp[4];
#pragma unroll
      for (int dt = 0; dt < 4; ++dt) tmp[dt] = f32x4{0.f, 0.f, 0.f, 0.f};
#pragma unroll
      for (int s2 = 0; s2 < 4; ++s2) {
        if (s2 >= npair) continue;
        s16x4 lo = pack4(s[2 * s2][0], s[2 * s2][1], s[2 * s2][2], s[2 * s2][3]);
        s16x4 hi = pack4(s[2 * s2 + 1][0], s[2 * s2 + 1][1], s[2 * s2 + 1][2], s[2 * s2 + 1][3]);
        bf16x8 pb = __builtin_shufflevector(lo, hi, 0, 1, 2, 3, 4, 5, 6, 7);
#pragma unroll
        for (int dt = 0; dt < 4; ++dt) {
          s16x4 vlo = lds_tr4(VcT + (s2 * 32 + fqz * 4 + (frz >> 2)) * 80 + dt * 16 + (frz & 3) * 4);
          s16x4 vhi = lds_tr4(VcT + (s2 * 32 + 16 + fqz * 4 + (frz >> 2)) * 80 + dt * 16 + (frz & 3) * 4);
          bf16x8 vf = __builtin_shufflevector(vlo, vhi, 0, 1, 2, 3, 4, 5, 6, 7);
          tmp[dt] = MFMA16(vf, pb, tmp[dt]);
        }
      }
      u32x4 lo4 = {cvt2(tmp[0][0] * g0, tmp[0][1] * g0), cvt2(tmp[0][2] * g0, tmp[0][3] * g0), cvt2(tmp[1][0] * g0, tmp[1][1] * g0), cvt2(tmp[1][2] * g0, tmp[1][3] * g0)};
      u32x4 hi4 = {cvt2(tmp[2][0] * g0, tmp[2][1] * g0), cvt2(tmp[2][2] * g0, tmp[2][3] * g0), cvt2(tmp[3][0] * g0, tmp[3][1] * g0), cvt2(tmp[3][2] * g0, tmp[3][3] * g0)};
      if (nt == 0) { ocp[0] = lo4; ocp[1] = hi4; } else { ocp[2] = lo4; ocp[3] = hi4; }
    }
    float* ia = impS + (hp * 64 + tg * 16 + fr) * 33;
    float* il = impL + (hp * 64 + tg * 16 + fr) * 33;
#pragma unroll
    for (int mt = 0; mt < 8; ++mt) {
      const int j = mt * 4 + fq;
      ia[j] = accA[mt];
      if (j < 31) il[j + 1] = accL[mt]; else il[0] = 0.f;
    }
  }
  __syncthreads();
#pragma unroll
  for (int q = 0; q < 4; ++q) ocS[q * 512 + tid] = ocp[q];
  unsigned sel;
  {
    const unsigned valid = (tq == 31) ? 0xffffffffu : ((1u << (tq + 1)) - 1u);
    unsigned forced = 1u | (1u << tq);
    if (tq > 0) forced |= 1u << (tq - 1);
    sel = forced & valid;
    int cnt = __popc(sel);
    float cand[8];
    {
      const float* a0 = impS + (tg * 16 + fr) * 33, *a1 = impS + (64 + tg * 16 + fr) * 33;
      const float* l0 = impL + (tg * 16 + fr) * 33, *l1 = impL + (64 + tg * 16 + fr) * 33;
#pragma unroll
      for (int mt = 0; mt < 8; ++mt) { const int j = mt * 4 + fq; cand[mt] = (a0[j] + a1[j]) + (l0[j] + l1[j]); }
    }
    for (int round = 0; round < 8; ++round) {
      if (cnt < 8) {
        const unsigned open = valid & ~sel;
        float bv = -1.f; int bj = 64;
#pragma unroll
        for (int mt = 0; mt < 8; ++mt) {
          const int j = mt * 4 + fq;
          if (((open >> j) & 1u) && cand[mt] > bv) { bv = cand[mt]; bj = j; }
        }
#pragma unroll
        for (int step = 0; step < 2; ++step) {
          const unsigned uv = __float_as_uint(bv), uj = (unsigned)bj;
          float v0, v1; int j0, j1;
          if (step == 0) {
            auto rv = __builtin_amdgcn_permlane16_swap(uv, uv, false, false); auto rj = __builtin_amdgcn_permlane16_swap(uj, uj, false, false);
            v0 = __uint_as_float(rv[0]); v1 = __uint_as_float(rv[1]); j0 = (int)rj[0]; j1 = (int)rj[1];
          } else {
            auto rv = __builtin_amdgcn_permlane32_swap(uv, uv, false, false); auto rj = __builtin_amdgcn_permlane32_swap(uj, uj, false, false);
            v0 = __uint_as_float(rv[0]); v1 = __uint_as_float(rv[1]); j0 = (int)rj[0]; j1 = (int)rj[1];
          }
          const bool take1 = (v1 > v0) || (v1 == v0 && j1 < j0);
          bv = take1 ? v1 : v0; bj = take1 ? j1 : j0;
        }
        if (bj < 32) { sel |= 1u << bj; cnt++; }
      }
    }
  }
  atomicOr(unionS, sel);
  f32x4 o[4][2];
  float m[2], l[2], qs[2];
  f32x4 idxf[4];
#pragma unroll
  for (int mt = 0; mt < 4; ++mt)
#pragma unroll
    for (int j = 0; j < 4; ++j) idxf[mt][j] = (float)(mt * 16 + fq * 4 + j);
#pragma unroll
  for (int r = 0; r < 2; ++r) {
    qs[r] = SC2 / slope2[r];
    m[r] = NEG_INF; l[r] = 0.f;
#pragma unroll
    for (int dt = 0; dt < 4; ++dt) o[dt][r] = f32x4{0.f, 0.f, 0.f, 0.f};
  }
  {
    const int kcol = C_KW + g * 64, vcol = C_VW + g * 64;
    int kt0 = t0 - 512; if (kt0 < 0) kt0 = 0; kt0 >>= 6;
    bf16x8 kr, vr;
    load_kv64(projb, tq * 64, kcol, vcol, tid, kr, vr);
    store_kv64(Ks, Vt, tid, kr, vr);
    __syncthreads();
    int cur = 0;
    for (int kt = tq; kt >= kt0; --kt) {
      const bool more = kt > kt0;
      if (more) load_kv64(projb, (kt - 1) * 64, kcol, vcol, tid, kr, vr);
      const int mode = (kt == tq) ? 1 : ((64 * (tq - kt) + 63 >= 512) ? 2 : 0);
      attn_tile64(Ks + cur * 64, Vt + cur * 64, qf, o, m, l, slope2, qs, idxf, kt * 64, tok, fr, fq, mode, 512, true);
      if (more) store_kv64(Ks + (cur ^ 1) * 64, Vt + (cur ^ 1) * 64, tid, kr, vr);
      __syncthreads();
      cur ^= 1;
    }
#pragma unroll
    for (int r = 0; r < 2; ++r) {
      float lt = l[r]; lt = xor16_sum(lt); lt = xor32_sum(lt);
      const float sc = (lt > 0.f ? 1.f / lt : 0.f) * p.gates[rowg * 24 + (g * 4 + hp * 2 + r) * 3 + 2];
#pragma unroll
      for (int half = 0; half < 2; ++half) {
        u32x4 oc = ocS[(r * 2 + half) * 512 + tid];
#pragma unroll
        for (int d2 = 0; d2 < 2; ++d2) {
          const int dt = half * 2 + d2;
          const unsigned c01 = oc[d2 * 2], c23 = oc[d2 * 2 + 1];
          oc[d2 * 2] = cvt2(o[dt][r][0] * sc + bf2f((us)(c01 & 0xffffu)), o[dt][r][1] * sc + bf2f((us)(c01 >> 16)));
          oc[d2 * 2 + 1] = cvt2(o[dt][r][2] * sc + bf2f((us)(c23 & 0xffffu)), o[dt][r][3] * sc + bf2f((us)(c23 >> 16)));
        }
        ocS[(r * 2 + half) * 512 + tid] = oc;
      }
      m[r] = NEG_INF; l[r] = 0.f;
#pragma unroll
      for (int dt = 0; dt < 4; ++dt) o[dt][r] = f32x4{0.f, 0.f, 0.f, 0.f};
    }
  }
  const unsigned uni = *unionS;
  {
    unsigned rem = uni;
    int j = 31 - __clz(rem); rem &= ~(1u << j);
    bf16x8 kr, vr;
    load_kv64(projb, j * 64, C_KS + g * 64, C_VS + g * 64, tid, kr, vr);
    store_kv64(Ks, Vt, tid, kr, vr);
    __syncthreads();
    int cur = 0;
    while (true) {
      const bool more = rem != 0u;
      const int jn = more ? (31 - __clz(rem)) : 0;
      if (more) rem &= ~(1u << jn);
      if (more) load_kv64(projb, jn * 64, C_KS + g * 64, C_VS + g * 64, tid, kr, vr);
      {
        const bool selj = ((sel >> j) & 1u) != 0;
        if (__ballot(selj) != 0ull)
          attn_tile64(Ks + cur * 64, Vt + cur * 64, qf, o, m, l, slope2, qs, idxf, j * 64, tok, fr, fq, (j == tq) ? 1 : 0, 0, selj);
      }
      if (more) store_kv64(Ks + (cur ^ 1) * 64, Vt + (cur ^ 1) * 64, tid, kr, vr);
      __syncthreads();
      if (!more) break;
      cur ^= 1; j = jn;
    }
  }
#pragma unroll
  for (int r = 0; r < 2; ++r) {
    float lt = l[r]; lt = xor16_sum(lt); lt = xor32_sum(lt);
    const float sc = (lt > 0.f ? 1.f / lt : 0.f) * p.gates[rowg * 24 + (g * 4 + hp * 2 + r) * 3 + 1];
    us* dst = p.attn + rowg * 1024 + (g * 4 + hp * 2 + r) * 64 + fq * 4;
#pragma unroll
    for (int half = 0; half < 2; ++half) {
      const u32x4 oc = ocS[(r * 2 + half) * 512 + tid];
#pragma unroll
      for (int d2 = 0; d2 < 2; ++d2) {
        const int dt = half * 2 + d2;
        const unsigned c01 = oc[d2 * 2], c23 = oc[d2 * 2 + 1];
        *(s16x4*)(dst + dt * 16) = pack4(o[dt][r][0] * sc + bf2f((us)(c01 & 0xffffu)), o[dt][r][1] * sc + bf2f((us)(c01 >> 16)),
                                         o[dt][r][2] * sc + bf2f((us)(c23 & 0xffffu)), o[dt][r][3] * sc + bf2f((us)(c23 >> 16)));
      }
    }
  }
}

DI void phase5(const Params& p) {
  const int tid = opaque_tid(), lane = tid & 63, wid = tid >> 6;
  const us* mix = p.a; us* mbuf = p.attn;
  for (int row = (blockIdx.x * 8 + wid) * 2; row < NTOK; row += gridDim.x * 16) {
    s16x4 mt[2][4]; float4 xv[2][4];
#pragma unroll
    for (int r = 0; r < 2; ++r)
#pragma unroll
      for (int i = 0; i < 4; ++i) {
        mt[r][i] = __builtin_nontemporal_load((const s16x4*)(mix + (size_t)(row + r) * 1024 + (lane + 64 * i) * 4));
        { f32x4 t = __builtin_nontemporal_load(((const f32x4*)(p.x + (size_t)(row + r) * 1024)) + lane + 64 * i); xv[r][i] = float4{t[0], t[1], t[2], t[3]}; }
      }
#pragma unroll
    for (int r = 0; r < 2; ++r) {
      float mv[4][4]; float ss = 0.f;
#pragma unroll
      for (int i = 0; i < 4; ++i)
#pragma unroll
        for (int j = 0; j < 4; ++j) { mv[i][j] = bf2f((us)mt[r][i][j]); ss += mv[i][j] * mv[i][j]; }
      ss = wave_sum(ss);
      const float r1 = rsqrtf(ss * (1.f / 1024.f) + EPS);
      float hv[4][4]; float ss2 = 0.f;
#pragma unroll
      for (int i = 0; i < 4; ++i) {
        float4 g = ((const float4*)p.g_mix_post)[lane + 64 * i];
        hv[i][0] = xv[r][i].x + mv[i][0] * r1 * g.x; hv[i][1] = xv[r][i].y + mv[i][1] * r1 * g.y;
        hv[i][2] = xv[r][i].z + mv[i][2] * r1 * g.z; hv[i][3] = xv[r][i].w + mv[i][3] * r1 * g.w;
#pragma unroll
        for (int j = 0; j < 4; ++j) ss2 += hv[i][j] * hv[i][j];
      }
      ss2 = wave_sum(ss2);
      const float r2 = rsqrtf(ss2 * (1.f / 1024.f) + EPS);
#pragma unroll
      for (int i = 0; i < 4; ++i) {
        float4 g = ((const float4*)p.g_mlp_pre)[lane + 64 * i];
        *(s16x4*)(mbuf + (size_t)(row + r) * 1024 + (lane + 64 * i) * 4) = pack4(hv[i][0] * r2 * g.x, hv[i][1] * r2 * g.y, hv[i][2] * r2 * g.z, hv[i][3] * r2 * g.w);
      }
    }
  }
}
DI void phase8(const Params& p) {
  const int tid = opaque_tid(), lane = tid & 63, wid = tid >> 6;
  const us* mix = p.a; const us* dn = p.attn;
  for (int row = (blockIdx.x * 8 + wid) * 2; row < NTOK; row += gridDim.x * 16) {
    s16x4 mt[2][4], dt[2][4]; float4 xv[2][4];
#pragma unroll
    for (int r = 0; r < 2; ++r)
#pragma unroll
      for (int i = 0; i < 4; ++i) {
        mt[r][i] = __builtin_nontemporal_load((const s16x4*)(mix + (size_t)(row + r) * 1024 + (lane + 64 * i) * 4));
        dt[r][i] = __builtin_nontemporal_load((const s16x4*)(dn + (size_t)(row + r) * 1024 + (lane + 64 * i) * 4));
        { f32x4 t = __builtin_nontemporal_load(((const f32x4*)(p.x + (size_t)(row + r) * 1024)) + lane + 64 * i); xv[r][i] = float4{t[0], t[1], t[2], t[3]}; }
      }
#pragma unroll
    for (int r = 0; r < 2; ++r) {
      float ss = 0.f, sd = 0.f;
#pragma unroll
      for (int i = 0; i < 4; ++i)
#pragma unroll
        for (int j = 0; j < 4; ++j) { float a = bf2f((us)mt[r][i][j]), b = bf2f((us)dt[r][i][j]); ss += a * a; sd += b * b; }
      ss = wave_sum(ss); sd = wave_sum(sd);
      const float r1 = rsqrtf(ss * (1.f / 1024.f) + EPS), r3 = rsqrtf(sd * (1.f / 1024.f) + EPS);
#pragma unroll
      for (int i = 0; i < 4; ++i) {
        float4 g1 = ((const float4*)p.g_mix_post)[lane + 64 * i];
        float4 g4 = ((const float4*)p.g_mlp_post)[lane + 64 * i];
        float4 h = xv[r][i];
        h.x = (h.x + bf2f((us)mt[r][i][0]) * r1 * g1.x) + bf2f((us)dt[r][i][0]) * r3 * g4.x;
        h.y = (h.y + bf2f((us)mt[r][i][1]) * r1 * g1.y) + bf2f((us)dt[r][i][1]) * r3 * g4.y;
        h.z = (h.z + bf2f((us)mt[r][i][2]) * r1 * g1.z) + bf2f((us)dt[r][i][2]) * r3 * g4.z;
        h.w = (h.w + bf2f((us)mt[r][i][3]) * r1 * g1.w) + bf2f((us)dt[r][i][3]) * r3 * g4.w;
        __builtin_nontemporal_store(f32x4{h.x, h.y, h.z, h.w}, ((f32x4*)(p.out + (size_t)(row + r) * 1024)) + lane + 64 * i);
      }
    }
  }
}

DI void late_weights_item(const Params& p, int item) {
  const int tid = opaque_tid(), lane = tid & 63, wid = tid >> 6;
  int i = item * 8 + wid;
  if (i < 256) { transpose_wave(p.w_out, 1024, 1024, p.wt_out, i / 16, i % 16, false, lane); return; }
  i -= 256;
  if (i < 1024) { transpose_wave(p.w_up, 1024, 4096, p.wt_up, i / 64, i % 64, false, lane); return; }
  i -= 1024;
  transpose_wave(p.w_down, 4096, 1024, p.wt_dn, i / 16, i % 16, false, lane);
}

DI void gates_rows(const Params& p, int row0, char* smem) {
  const int tid = opaque_tid(), lane = tid & 63, w = tid >> 6, fr = lane & 15, fq = lane >> 4;
  us* Bs = (us*)smem;
  __syncthreads();
#pragma unroll
  for (int i = 0; i < 8; ++i) {
    int c = tid + 512 * i, r = c >> 7, ch = c & 127;
    *(bf16x8*)(Bs + r * 1032 + ch * 8) = *(const bf16x8*)(p.wt_in + (size_t)(2048 + r) * 1024 + ch * 8);
  }
  __syncthreads();
  const us* ap = p.a + (size_t)(row0 + w * 16 + fr) * 1024 + fq * 8;
  const us* bp = Bs + fr * 1032 + fq * 8;
  f32x4 acc[2] = {f32x4{0.f, 0.f, 0.f, 0.f}, f32x4{0.f, 0.f, 0.f, 0.f}};
#pragma unroll 8
  for (int ks = 0; ks < 32; ++ks) {
    bf16x8 af = *(const bf16x8*)(ap + ks * 32);
    bf16x8 b0 = *(const bf16x8*)(bp + ks * 32);
    bf16x8 b1 = *(const bf16x8*)(bp + 16 * 1032 + ks * 32);
    acc[0] = MFMA16(b0, af, acc[0]);
    acc[1] = MFMA16(b1, af, acc[1]);
  }
  float* gp = p.gates + (size_t)(row0 + w * 16 + fr) * 24;
#pragma unroll
  for (int n = 0; n < 2; ++n) {
    if (n == 0 || fq < 2) {
      f32x4 o;
#pragma unroll
      for (int j = 0; j < 4; ++j) o[j] = 1.f / (1.f + __expf(-acc[n][j]));
      *(f32x4*)(gp + n * 16 + fq * 4) = o;
    }
  }
}

constexpr int LDS_BYTES = 131072 + 16;
__global__ void __launch_bounds__(512, 2) mega(Params p) {
  extern __shared__ __attribute__((aligned(16))) char smem[];
  cg::grid_group grid = cg::this_grid();
  if (p.phase_hi > NPH) grid.sync();
  volatile LAS unsigned* xst = (volatile LAS unsigned*)(smem + 131072);
  if (threadIdx.x < 4) xst[threadIdx.x] = 0u;
  __syncthreads();
  const XcdBarrier xb = xcd_barrier_post(p.bar, xst);
  for (int ph = p.phase_lo; ph < p.phase_hi; ++ph) {
    const bool is_gemm = (ph == 1) | (ph == 4) | (ph == 6) | (ph == 7);
    if (is_gemm) {
      const us* A = (ph == 1) ? p.a : (ph == 7 ? p.u : p.attn);
      const us* Bt = (ph == 1) ? p.wt_in : (ph == 4 ? p.wt_out : (ph == 6 ? p.wt_up : p.wt_dn));
      us* O = (ph == 1) ? p.proj : (ph == 6 ? p.u : (ph == 4 ? p.a : p.attn));
      const int N = (ph == 1) ? 2048 : (ph == 6 ? 4096 : 1024);
      const int K = (ph == 7) ? 4096 : 1024;
      const bool gates_first = (ph == 1) && (((blockIdx.x >> 3) & 1) != 0);
      if (gates_first) {
        for (int r0 = blockIdx.x * 128; r0 < NTOK; r0 += gridDim.x * 128) gates_rows(p, r0, smem);
        __syncthreads();
      }
      pg8::StaticOrder S; S.init(NTOK, N, (int)gridDim.x, (int)blockIdx.x);
      pg8::Gemm g{A, Bt, NTOK, N, K};
      EpiB16 E{O, N, ph == 6 ? 1 : 0};
      pg8::gemm_phase<EpiB16, pg8::StaticOrder, false>((PG8_LAS unsigned char*)smem, g, S, E, nullptr);
      if (ph == 1 && !gates_first)
        for (int r0 = blockIdx.x * 128; r0 < NTOK; r0 += gridDim.x * 128) gates_rows(p, r0, smem);
    } else if (ph == 0) {
      phase0(p, smem);
    } else if (ph == 2 || ph == 3) {
      volatile LAS int* qslot = (volatile LAS int*)(smem + 131072 + 8);
      unsigned* ctr = p.bar + 3584 + (ph - 2) * 64;
      const int nitems = (ph == 2) ? 256 : (1024 + 1024 + 288);
      int it = blockIdx.x;
      while (it < nitems) {
        int nx = 0;
        if (threadIdx.x == 0) nx = (int)gridDim.x + (int)atomicAdd(ctr, 1u);
        if (ph == 2) {
          compress_item(p, it, smem);
        } else if (it < 1024) {
          int g = 1 - (it >> 9), r9 = it & 511;
          nsa_item(p, r9 & 15, g, 31 - (r9 >> 4), smem);
        } else if (it < 2048) {
          int i = it - 1024;
          int tq = 31 - (i >> 5), rem = i & 31;
          banded_item(p, rem >> 1, rem & 1, tq, 1, smem);
        } else {
          late_weights_item(p, it - 2048);
        }
        if (threadIdx.x == 0) *qslot = nx;
        __syncthreads();
        it = *qslot;
        __syncthreads();
      }
    } else if (ph == 5) {
      phase5(p);
    } else {
      phase8(p);
    }
    if (ph + 1 < p.phase_hi) xcd_barrier(xb);
  }
}

extern "C" void kernel_launch(void* const* d_in, const int* in_sizes, int n_in, void* d_out, int out_size, void* d_ws, size_t ws_size,
                              hipStream_t stream) {
  static int grid_blocks = 0;
  if (!grid_blocks) {
    int dev = 0, cus = 0, per_cu = 0;
    (void)hipGetDevice(&dev);
    (void)hipDeviceGetAttribute(&cus, hipDeviceAttributeMultiprocessorCount, dev);
    (void)hipFuncSetAttribute((const void*)mega, hipFuncAttributeMaxDynamicSharedMemorySize, LDS_BYTES);
    (void)hipOccupancyMaxActiveBlocksPerMultiprocessor(&per_cu, (const void*)mega, 512, LDS_BYTES);
    if (per_cu < 1) per_cu = 1;
    if (per_cu > 1) per_cu = 1;
    grid_blocks = cus * per_cu;
  }
  Params p{};
  const float* const* in = (const float* const*)d_in;
  p.x = in[0]; p.g_mix_pre = in[1]; p.w_in = in[2]; p.pe_k = in[3]; p.w1_k = in[4]; p.w2_k = in[5]; p.pe_v = in[6]; p.w1_v = in[7];
  p.w2_v = in[8]; p.sinks = in[9]; p.w_out = in[10]; p.g_mix_post = in[11]; p.g_mlp_pre = in[12]; p.w_up = in[13]; p.w_down = in[14];
  p.g_mlp_post = in[15];
  p.out = (float*)d_out;
  char* ws = (char*)d_ws;
  const size_t MB = 1024 * 1024;
  p.a = (us*)(ws);
  p.attn = (us*)(ws + 64 * MB);
  p.proj = (us*)(ws + 128 * MB);
  p.u = (us*)(ws + 128 * MB);
  char* w = ws + 384 * MB;
  p.wt_in = (us*)w;  w += (size_t)2176 * 1024 * 2;
  p.wt_out = (us*)w; w += (size_t)1024 * 1024 * 2;
  p.wt_up = (us*)w;  w += (size_t)4096 * 1024 * 2;
  p.wt_dn = (us*)w;  w += (size_t)4096 * 1024 * 2;
  p.w1t_k = (us*)w;  w += (size_t)256 * 2048 * 2;
  p.w1t_v = (us*)w;  w += (size_t)256 * 2048 * 2;
  p.w2t_k = (us*)w;  w += (size_t)64 * 256 * 2;
  p.w2t_v = (us*)w;  w += (size_t)64 * 256 * 2;
  p.gates = (float*)w; w += (size_t)NTOK * 24 * 4;
  p.kcf = (float*)w; w += (size_t)32 * 128 * 64 * 4;
  p.vcf = (float*)w; w += (size_t)32 * 128 * 64 * 4;
  p.bar = (unsigned*)w; w += 16384;
  (void)hipMemsetAsync(p.bar, 0, 16384, stream);
  p.phase_lo = 0; p.phase_hi = NPH;
  void* args[] = {&p};
  hipError_t e = hipLaunchCooperativeKernel((const void*)mega, dim3(grid_blocks), dim3(512), args, LDS_BYTES, stream);
  if (e != hipSuccess) fprintf(stderr, "cooperative launch failed: %s (grid %d)\n", hipGetErrorString(e), grid_blocks);
}
```

```cpp
#include <hip/hip_runtime.h>
#include <hip/hip_cooperative_groups.h>
#include <cstdio>
namespace cg = cooperative_groups;

typedef unsigned short us;
typedef __attribute__((ext_vector_type(8))) short bf16x8;
typedef __attribute__((ext_vector_type(4))) short s16x4;
typedef __attribute__((ext_vector_type(4))) float f32x4;

#define DI __device__ __forceinline__
#define MFMA16(a, b, c) __builtin_amdgcn_mfma_f32_16x16x32_bf16((a), (b), (c), 0, 0, 0)

constexpr int T = 2048;
constexpr int NTOK = 32768;
constexpr int LDP = 2048;
constexpr int NPH = 9;
constexpr float LOG2E = 1.4426950408889634f;
constexpr float SC2 = 0.125f * 1.4426950408889634f;
constexpr float EPS = 1e-6f;
#define NEG_INF (-__builtin_inff())

constexpr int C_QN = 0, C_KC = 512, C_VC = 640, C_KS = 768, C_VS = 896, C_KW = 1024, C_VW = 1152, C_QS = 1280, C_KSW = 1792, C_VSW = 1920;

struct Params {
  const float *x, *g_mix_pre, *w_in, *pe_k, *w1_k, *w2_k, *pe_v, *w1_v, *w2_v, *sinks, *w_out, *g_mix_post, *g_mlp_pre, *w_up, *w_down, *g_mlp_post;
  float* out;
  us *wt_in, *wt_out, *wt_up, *wt_dn, *w1t_k, *w1t_v, *w2t_k, *w2t_v;
  us *a, *proj, *attn, *u;
  float *gates, *kcf, *vcf;
  unsigned* bar;
  int phase_lo, phase_hi;
};

DI us f2bf(float x) { unsigned u = __float_as_uint(x); u += 0x7fffu + ((u >> 16) & 1u); return (us)(u >> 16); }
DI float bf2f(us h) { return __uint_as_float(((unsigned)h) << 16); }
DI int opaque_tid() { int t = threadIdx.x; asm volatile("" : "+v"(t)); return t; }
DI float ex2(float x) { return __builtin_amdgcn_exp2f(x); }
DI float xor16_max(float x) { unsigned u = __float_as_uint(x); auto r = __builtin_amdgcn_permlane16_swap(u, u, false, false); return fmaxf(__uint_as_float(r[0]), __uint_as_float(r[1])); }
DI float xor32_max(float x) { unsigned u = __float_as_uint(x); auto r = __builtin_amdgcn_permlane32_swap(u, u, false, false); return fmaxf(__uint_as_float(r[0]), __uint_as_float(r[1])); }
DI float xor16_sum(float x) { unsigned u = __float_as_uint(x); auto r = __builtin_amdgcn_permlane16_swap(u, u, false, false); return __uint_as_float(r[0]) + __uint_as_float(r[1]); }
DI float xor32_sum(float x) { unsigned u = __float_as_uint(x); auto r = __builtin_amdgcn_permlane32_swap(u, u, false, false); return __uint_as_float(r[0]) + __uint_as_float(r[1]); }
DI s16x4 lds_tr4(const us* p) { return __builtin_amdgcn_ds_read_tr16_b64_v4i16((__attribute__((address_space(3))) s16x4*)p); }
DI float wave_sum(float v) {
#pragma unroll
  for (int o = 32; o >= 1; o >>= 1) v += __shfl_xor(v, o);
  return v;
}
typedef __bf16 bf2_t __attribute__((ext_vector_type(2)));
typedef float f2_t __attribute__((ext_vector_type(2)));
typedef unsigned u32x2 __attribute__((ext_vector_type(2)));
typedef unsigned u32x4 __attribute__((ext_vector_type(4)));
DI unsigned cvt2(float lo, float hi) { f2_t v = {lo, hi}; return __builtin_bit_cast(unsigned, __builtin_convertvector(v, bf2_t)); }
DI s16x4 pack4(float a, float b, float c, float d) { u32x2 r = {cvt2(a, b), cvt2(c, d)}; return __builtin_bit_cast(s16x4, r); }

#define XB_TMO      128
#define XB_XCNT(j)  (256  + 64 * (j))
#define XB_XSUB(j)  (1280 + 64 * (j))
#define XB_XGEN(j)  (2304 + 64 * (j))
#define XB_TOP      3328
#define XB_TOPGEN   3392
#define XCD_BAR_WORDS 3456
#define XB_SPIN_CAP (1u << 18)
#define LAS __attribute__((address_space(3)))

__device__ __forceinline__ unsigned xb_ld(unsigned* p)              { return __hip_atomic_load(p, __ATOMIC_RELAXED, __HIP_MEMORY_SCOPE_AGENT); }
__device__ __forceinline__ unsigned xb_add(unsigned* p, unsigned v) { return __hip_atomic_fetch_add(p, v, __ATOMIC_RELAXED, __HIP_MEMORY_SCOPE_AGENT); }
__device__ __forceinline__ unsigned xb_xcc_id() { return (unsigned)__builtin_amdgcn_s_getreg((3 << 11) | 20) & 0xFu; }
#define XB_SPIN(cond, bar) do { unsigned _sp = 0; while (cond) { __builtin_amdgcn_s_sleep(0); \
    if ((++_sp & 255u) == 0u) { if (xb_ld(&(bar)[XB_TMO])) break; if (_sp > XB_SPIN_CAP) { atomicAdd(&(bar)[XB_TMO], 1u); break; } } } } while (0)

struct XcdBarrier {
    unsigned* bar; unsigned x;
    volatile LAS unsigned* st;
};

__device__ __forceinline__ XcdBarrier xcd_barrier_post(unsigned* bar, volatile LAS unsigned* st) {
    XcdBarrier b; b.bar = bar; b.x = xb_xcc_id(); b.st = st;
    if (threadIdx.x == 0) (void)xb_add(&bar[XB_XCNT(b.x)], 1u);
    return b;
}
__device__ __forceinline__ void xcd_barrier_complete(unsigned* bar, unsigned x, unsigned& nloc, unsigned& nx) {
    const unsigned G = gridDim.x * gridDim.y * gridDim.z;
    unsigned sum, cnt, mine, sp = 0u;
    for (;;) {
        sum = 0u; cnt = 0u; mine = 0u;
#pragma unroll
        for (unsigned j = 0; j < 16; ++j) { const unsigned c = xb_ld(&bar[XB_XCNT(j)]); sum += c; cnt += (c > 0u) ? 1u : 0u; mine = (j == x) ? c : mine; }
        if (sum == G) break;
        __builtin_amdgcn_s_sleep(1);
        if ((++sp & 255u) == 0u) { if (xb_ld(&bar[XB_TMO])) break; if (sp > XB_SPIN_CAP) { atomicAdd(&bar[XB_TMO], 1u); break; } }
    }
    nloc = mine > 0u ? mine : 1u; nx = cnt > 0u ? cnt : 1u;
}

__device__ __forceinline__ void xcd_barrier(const XcdBarrier& b) {
    asm volatile("s_waitcnt vmcnt(0)" ::: "memory");
    __syncthreads();
    if (threadIdx.x == 0) {
        unsigned* bar = b.bar;
        __builtin_amdgcn_s_waitcnt(0);
        unsigned nloc = b.st[0], nx = b.st[1];
        if (nloc == 0u) { xcd_barrier_complete(bar, b.x, nloc, nx); b.st[0] = nloc; b.st[1] = nx; }
        const unsigned old = xb_add(&bar[XB_XSUB(b.x)], 1u);
        const unsigned gen = old / nloc;
        if (old + 1u == (gen + 1u) * nloc) {
            __builtin_amdgcn_fence(__ATOMIC_RELEASE, "agent");
            asm volatile("s_waitcnt vmcnt(0)" ::: "memory");
            const unsigned og = xb_add(&bar[XB_TOP], 1u);
            const unsigned tg = og / nx;
            if (og + 1u == (tg + 1u) * nx) xb_add(&bar[XB_TOPGEN], 1u);
            else XB_SPIN(xb_ld(&bar[XB_TOPGEN]) == tg, bar);
            __builtin_amdgcn_fence(__ATOMIC_ACQUIRE, "agent");
            xb_add(&bar[XB_XGEN(b.x)], 1u);
            asm volatile("s_waitcnt vmcnt(0)" ::: "memory");
        } else {
            XB_SPIN(xb_ld(&bar[XB_XGEN(b.x)]) == gen, bar);
            __builtin_amdgcn_fence(__ATOMIC_ACQUIRE, "agent");
            asm volatile("s_waitcnt vmcnt(0)" ::: "memory");
        }
    }
    __syncthreads();
}


namespace pg8 {
#define PG8_LAS __attribute__((address_space(3)))
typedef unsigned short bf16_t;
typedef short bf16x8 __attribute__((ext_vector_type(8)));
typedef float f32x4 __attribute__((ext_vector_type(4)));
typedef unsigned u32x4 __attribute__((ext_vector_type(4)));
constexpr int BM = 256, BK = 64, HALF = 128, HTB = HALF * BK * 2  , STAGE_BYTES = 8 * HTB, NXCD = 8, WGM = 8;

__host__ __device__ __forceinline__ int lds_byte(int r, int c) { const int st = (r >> 4) * 2 + (c >> 5), rr = r & 15, cc = c & 31, ob = rr * 64 + cc * 2; return st * 1024 + (ob ^ (((ob >> 9) & 1) << 5)); }
__host__ __device__ __forceinline__ void stage_rc(int b, int& R, int& C) { const int st = b / 1024, sb = b % 1024, swz = sb ^ (((sb >> 9) & 1) << 5); R = (st >> 1) * 16 + swz / 64; C = (st & 1) * 32 + (swz % 64) / 2; }
__host__ __device__ __forceinline__ int perm32(int rho) { const int n = rho >> 4, i = rho & 15; return 8 * (i >> 2) + 4 * n + (i & 3); }

struct Unit { int pm, pn; };
struct Gemm { const bf16_t* A; const bf16_t* Bt; int M, N, K; };

struct StaticOrder {
    int nM, nN, nwg, G, c;
    __host__ __device__ void init(int M, int N, int G_, int c_) { nM = M / BM; nN = N / BM; nwg = nM * nN; G = G_; c = c_; }
    __host__ __device__ bool next(int i, Unit& u) const {
        const long L = (long)i * G + c; if (L >= nwg) return false;
        int wgid = (int)L; { const int q = nwg / NXCD, r = nwg % NXCD, xcd = wgid % NXCD, off = wgid / NXCD; wgid = (xcd < r ? xcd * (q + 1) : r * (q + 1) + (xcd - r) * q) + off; }
        const int nig = WGM * nN, gid = wgid / nig, fm = gid * WGM, gsz = (nM - fm) < WGM ? (nM - fm) : WGM;
        u.pm = fm + ((wgid % nig) % gsz); u.pn = (wgid % nig) / gsz; return true;
    }
    __device__ __forceinline__ void a_ready(const Unit&) const {}
    __device__ __forceinline__ void done(const Unit&) const {}
};
template <class Epi, class Sched, bool STAMP = false>
__device__ __forceinline__ void gemm_phase(PG8_LAS unsigned char* lds, const Gemm g, const Sched& S, const Epi& E, unsigned long long* stamps) {
    const int tid = opaque_tid(), wid = __builtin_amdgcn_readfirstlane(tid >> 6), lane = tid & 63, wr = wid >> 2, wc = wid & 3, fr = lane & 15, fq = lane >> 4;
    const int K = g.K, nt = K / BK;
    int ts_lo = 0, ts_hi = 0, nts = 0; const unsigned long long rt_entry = STAMP ? (unsigned long long)wall_clock64() : 0ull;
#define PG8_STAMP() do { if (STAMP && wid == 0 && nts < 64) { const unsigned long long _c = (unsigned long long)clock64(); \
        ts_lo = (lane == nts) ? (int)(unsigned)_c : ts_lo; ts_hi = (lane == nts) ? (int)(unsigned)(_c >> 32) : ts_hi; ++nts; } } while (0)
    PG8_STAMP();
    unsigned voffA[2], voffB[2];
#pragma unroll
    for (int i = 0; i < 2; ++i) { int R, C; stage_rc(tid * 16 + i * 8192, R, C); const int Rb = Epi::PERM ? ((R & ~31) + perm32(R & 31)) : R;
        voffA[i] = (unsigned)(R * K + C) * 2u; voffB[i] = (unsigned)(Rb * K + C) * 2u; }
    const size_t kstep = (size_t)(BK * 2);
    const size_t hstep = (size_t)HALF * K * 2;
    const size_t tstep = 2 * hstep;
    const unsigned ldsw = (unsigned)wid * 1024u;
    const int aoff = lds_byte(wr * 64 + fr, fq * 8), boff = lds_byte(wc * 32 + fr, fq * 8);
#define PG8_SA(b, h) (((b) * 2 + (h)) * HTB)
#define PG8_SB(b, h) ((4 + (b) * 2 + (h)) * HTB)
#define PG8_STAGE(bufoff, gbase, voff) do { _Pragma("unroll") for (int _i = 0; _i < 2; ++_i) \
        __builtin_amdgcn_global_load_lds((const unsigned*)((const char*)(gbase) + (voff)[_i]), (PG8_LAS unsigned*)(lds + (bufoff) + ldsw + _i * 8192), 16, 0, 0); } while (0)
#define PG8_LDA(dst, b, h) do { _Pragma("unroll") for (int m = 0; m < 4; ++m) _Pragma("unroll") for (int k = 0; k < 2; ++k) dst[m][k] = *(const PG8_LAS bf16x8*)(lds + PG8_SA(b, h) + aoff + m * 2048 + k * 1024); } while (0)
#define PG8_LDB(dst, b, h) do { _Pragma("unroll") for (int n = 0; n < 2; ++n) _Pragma("unroll") for (int k = 0; k < 2; ++k) dst[n][k] = *(const PG8_LAS bf16x8*)(lds + PG8_SB(b, h) + boff + n * 2048 + k * 1024); } while (0)
#define PG8_MMA(ai, bj, At, Bt) do { __builtin_amdgcn_s_setprio(1); _Pragma("unroll") for (int m = 0; m < 4; ++m) _Pragma("unroll") for (int n = 0; n < 2; ++n) _Pragma("unroll") for (int k = 0; k < 2; ++k) \
        acc[ai][bj][m][n] = __builtin_amdgcn_mfma_f32_16x16x32_bf16(Bt[n][k], At[m][k], acc[ai][bj][m][n], 0, 0, 0); __builtin_amdgcn_s_setprio(0); } while (0)
#define PG8_WAIT_V(n) asm volatile("s_waitcnt vmcnt(" #n ")" ::: "memory")
#define PG8_WAIT_L(n) asm volatile("s_waitcnt lgkmcnt(" #n ")" ::: "memory")
#define PG8_BAR __builtin_amdgcn_s_barrier()
#define PG8_SCHED __builtin_amdgcn_sched_barrier(0)
    Unit cur, nxt; int ui = 0;
    if (!S.next(0, cur)) return;
    f32x4 acc[2][2][4][2];
#pragma unroll
    for (int a = 0; a < 2; ++a)
#pragma unroll
        for (int b = 0; b < 2; ++b)
#pragma unroll
            for (int m = 0; m < 4; ++m)
#pragma unroll
                for (int n = 0; n < 2; ++n) acc[a][b][m][n] = (f32x4){0.f, 0.f, 0.f, 0.f};
    bf16x8 At[4][2], B0[2][2], B1[2][2];
    const char* cA = (const char*)g.A + (size_t)cur.pm * tstep; const char* cB = (const char*)g.Bt + (size_t)cur.pn * tstep;
    S.a_ready(cur);
    PG8_STAGE(PG8_SB(0, 0), cB, voffB); PG8_STAGE(PG8_SA(0, 0), cA, voffA); PG8_STAGE(PG8_SB(0, 1), cB + hstep, voffB); PG8_STAGE(PG8_SA(0, 1), cA + hstep, voffA);
    if (wr == 1) PG8_BAR;
    PG8_WAIT_V(4); PG8_BAR;
    PG8_STAGE(PG8_SB(1, 0), cB + kstep, voffB); PG8_STAGE(PG8_SA(1, 0), cA + kstep, voffA); PG8_STAGE(PG8_SB(1, 1), cB + hstep + kstep, voffB);
    PG8_WAIT_V(6); PG8_BAR;
    PG8_STAMP();
    for (;;) {
        const bool has_next = S.next(ui + 1, nxt);
        const char* nA = has_next ? (const char*)g.A + (size_t)nxt.pm * tstep : cA; const char* nB = has_next ? (const char*)g.Bt + (size_t)nxt.pn * tstep : cB;
        for (int t = 0; t < nt; t += 2) {
            const bool last = (t == nt - 2);
            const char* a1 = cA + (size_t)(t + 1) * kstep;
            const char* a2 = last ? nA : cA + (size_t)(t + 2) * kstep; const char* b2 = last ? nB : cB + (size_t)(t + 2) * kstep;
            const char* a3 = a2 + kstep; const char* b3 = b2 + kstep;
            if (last && has_next) S.a_ready(nxt);
            PG8_LDB(B0, 0, 0); PG8_SCHED; PG8_LDA(At, 0, 0); PG8_STAGE(PG8_SA(1, 1), a1 + hstep, voffA);
            PG8_WAIT_L(8); PG8_BAR; PG8_WAIT_L(0); PG8_MMA(0, 0, At, B0); PG8_BAR; PG8_SCHED;
            PG8_LDB(B1, 0, 1); PG8_STAGE(PG8_SB(0, 0), b2, voffB);
            PG8_BAR; PG8_WAIT_L(0); PG8_MMA(0, 1, At, B1); PG8_BAR;
            PG8_LDA(At, 0, 1); PG8_STAGE(PG8_SA(0, 0), a2, voffA);
            PG8_BAR; PG8_WAIT_L(0); PG8_MMA(1, 0, At, B0); PG8_BAR; PG8_SCHED;
            PG8_STAGE(PG8_SB(0, 1), b2 + hstep, voffB);
            PG8_WAIT_V(6); PG8_BAR; PG8_MMA(1, 1, At, B1); PG8_BAR;
            PG8_LDB(B0, 1, 0); PG8_SCHED; PG8_LDA(At, 1, 0); PG8_STAGE(PG8_SA(0, 1), a2 + hstep, voffA);
            PG8_WAIT_L(8); PG8_BAR; PG8_WAIT_L(0); PG8_MMA(0, 0, At, B0); PG8_BAR; PG8_SCHED;
            PG8_LDB(B1, 1, 1); PG8_STAGE(PG8_SB(1, 0), b3, voffB);
            PG8_BAR; PG8_WAIT_L(0); PG8_MMA(0, 1, At, B1); PG8_BAR;
            PG8_LDA(At, 1, 1); PG8_STAGE(PG8_SA(1, 0), a3, voffA);
            PG8_BAR; PG8_WAIT_L(0); PG8_MMA(1, 0, At, B0); PG8_BAR; PG8_SCHED;
            PG8_STAGE(PG8_SB(1, 1), b3 + hstep, voffB);
            PG8_WAIT_V(6); PG8_BAR; PG8_MMA(1, 1, At, B1); PG8_BAR;
        }
        PG8_STAMP();
        if constexpr (!Epi::AFTER_DRAIN) { E(acc, cur, wr, wc, fr, fq); S.done(cur); }
        PG8_STAMP();
        if (!has_next) break;
#pragma unroll
        for (int a = 0; a < 2; ++a)
#pragma unroll
            for (int b = 0; b < 2; ++b)
#pragma unroll
                for (int m = 0; m < 4; ++m)
#pragma unroll
                    for (int n = 0; n < 2; ++n) acc[a][b][m][n] = (f32x4){0.f, 0.f, 0.f, 0.f};
        cur = nxt; cA = nA; cB = nB; ++ui;
    }
    PG8_WAIT_V(0);
    if (wr == 0) PG8_BAR;
    PG8_BAR;
    if constexpr (Epi::AFTER_DRAIN) { E.fused(acc, cur, wr, wc, fr, fq, lds, wid, lane); S.done(cur); }
    PG8_STAMP();
    if (STAMP && wid == 0) { stamps[lane] = lane < nts ? (((unsigned long long)(unsigned)ts_hi << 32) | (unsigned)ts_lo) : 0ull;
        if (lane == 62) stamps[62] = rt_entry; if (lane == 63) stamps[63] = (unsigned long long)wall_clock64(); }
#undef PG8_STAMP
#undef PG8_SA
#undef PG8_SB
#undef PG8_STAGE
#undef PG8_LDA
#undef PG8_LDB
#undef PG8_MMA
#undef PG8_WAIT_V
#undef PG8_WAIT_L
#undef PG8_BAR
#undef PG8_SCHED
}
}

struct EpiB16 {
  static constexpr bool PERM = true, AFTER_DRAIN = false;
  us* O; int ldc; int ACT;
  DI void operator()(const f32x4 (&acc)[2][2][4][2], const pg8::Unit& u, int wr, int wc, int fr, int fq) const {
    const int row0 = u.pm * 256 + wr * 64 + fr, col0 = u.pn * 256 + wc * 32 + 8 * fq;
#pragma unroll
    for (int ai = 0; ai < 2; ++ai)
#pragma unroll
      for (int m = 0; m < 4; ++m) {
        us* rowp = O + (size_t)(row0 + ai * 128 + m * 16) * ldc + col0;
#pragma unroll
        for (int bj = 0; bj < 2; ++bj) {
          f32x4 v0 = acc[ai][bj][m][0], v1 = acc[ai][bj][m][1];
          if (ACT == 1) {
#pragma unroll
            for (int j = 0; j < 4; ++j) { float a = fmaxf(v0[j], 0.f), b = fmaxf(v1[j], 0.f); v0[j] = a * a; v1[j] = b * b; }
          }
          u32x4 w = {cvt2(v0[0], v0[1]), cvt2(v0[2], v0[3]), cvt2(v1[0], v1[1]), cvt2(v1[2], v1[3])};
          *(u32x4*)(rowp + bj * 128) = w;
        }
      }
  }
};

struct ALoadCmp {
  const us* base;
  const float* pe;
  int r0;
  DI bf16x8 operator()(int r, int kt, int kc) const {
    int n = r + r0; n = n < 126 ? n : 126;
    bf16x8 v = *(const bf16x8*)(base + (size_t)(16 * n + kt) * LDP + kc * 8);
    const float* pp = pe + kt * 64 + kc * 8;
    bf16x8 o;
#pragma unroll
    for (int e = 0; e < 8; ++e) o[e] = (short)f2bf(bf2f((us)v[e]) + pp[e]);
    return o;
  }
};

template <int MW, class AL, class EPI>
DI void gemm_tile(const AL& al, const us* __restrict__ Bt, int ldb, int n0, int nk  , const EPI& epi, char* smem) {
  constexpr int BM = MW * 64, NW = 8 / MW, NT = 128 / NW / 16, AI = BM * 8 / 512, STG = (BM + 128) * 80;
  us(*As)[80] = (us(*)[80])smem;
  us(*Bs)[80] = (us(*)[80])(smem + BM * 80 * 2);
  const int tid = opaque_tid(), lane = tid & 63, wid = tid >> 6, wr = wid / NW, wc = wid % NW, fr = lane & 15, fq = lane >> 4;
  f32x4 acc[4][NT];
#pragma unroll
  for (int m = 0; m < 4; ++m)
#pragma unroll
    for (int n = 0; n < NT; ++n) acc[m][n] = f32x4{0.f, 0.f, 0.f, 0.f};
  bf16x8 ra0[AI], rb0[2], ra1[AI], rb1[2];
#define GT_LOAD(RA, RB, KT) do { \
    _Pragma("unroll") for (int i = 0; i < AI; ++i) { int c = tid + 512 * i, r = c >> 3, kc = c & 7; RA[i] = al(r, (KT), kc); } \
    _Pragma("unroll") for (int i = 0; i < 2; ++i) { int c = tid + 512 * i, r = c >> 3, kc = c & 7; RB[i] = *(const bf16x8*)(Bt + (size_t)(n0 + r) * ldb + (KT) * 64 + kc * 8); } } while (0)
#define GT_STORE(RA, RB, S) do { \
    _Pragma("unroll") for (int i = 0; i < AI; ++i) { int c = tid + 512 * i, r = c >> 3, kc = c & 7; *(bf16x8*)&As[(S) * (BM + 128) + r][kc * 8] = RA[i]; } \
    _Pragma("unroll") for (int i = 0; i < 2; ++i) { int c = tid + 512 * i, r = c >> 3, kc = c & 7; *(bf16x8*)&Bs[(S) * (BM + 128) + r][kc * 8] = RB[i]; } } while (0)
#define GT_COMPUTE(S) do { \
    _Pragma("unroll") for (int ks = 0; ks < 2; ++ks) { \
      bf16x8 af[4], bfr[NT]; \
      _Pragma("unroll") for (int m = 0; m < 4; ++m) af[m] = *(const bf16x8*)&As[(S) * (BM + 128) + wr * 64 + m * 16 + fr][ks * 32 + fq * 8]; \
      _Pragma("unroll") for (int n = 0; n < NT; ++n) bfr[n] = *(const bf16x8*)&Bs[(S) * (BM + 128) + wc * (NT * 16) + n * 16 + fr][ks * 32 + fq * 8]; \
      _Pragma("unroll") for (int m = 0; m < 4; ++m) _Pragma("unroll") for (int n = 0; n < NT; ++n) acc[m][n] = MFMA16(bfr[n], af[m], acc[m][n]); } } while (0)
  GT_LOAD(ra0, rb0, 0);
  GT_LOAD(ra1, rb1, 1);
  __syncthreads();
  GT_STORE(ra0, rb0, 0);
  __syncthreads();
  for (int kt = 0; kt < nk; kt += 2) {
    if (kt + 2 < nk) GT_LOAD(ra0, rb0, kt + 2);
    GT_COMPUTE(0);
    GT_STORE(ra1, rb1, 1);
    __syncthreads();
    if (kt + 3 < nk) GT_LOAD(ra1, rb1, kt + 3);
    GT_COMPUTE(1);
    if (kt + 2 < nk) GT_STORE(ra0, rb0, 0);
    __syncthreads();
  }
#undef GT_LOAD
#undef GT_STORE
#undef GT_COMPUTE
#pragma unroll
  for (int m = 0; m < 4; ++m)
#pragma unroll
    for (int n = 0; n < NT; ++n) epi(wr * 64 + m * 16 + fr, wc * (NT * 16) + n * 16 + fq * 4, acc[m][n]);
}

struct EpiGeluLds {
  us* Hs;
  DI void operator()(int r, int c, f32x4 v) const {
    float o[4];
#pragma unroll
    for (int j = 0; j < 4; ++j) {
      float xx = v[j];
      float t = tanhf(0.7978845608028654f * (xx + 0.044715f * xx * xx * xx));
      o[j] = 0.5f * xx * (1.f + t);
    }
    *(s16x4*)(Hs + r * 136 + c) = pack4(o[0], o[1], o[2], o[3]);
  }
};

DI int remap_win(int n) { return n < 1280 ? n : (n < 1304 ? n + 768 : n - 24); }

DI void transpose_wave(const float* __restrict__ src, int K, int N, us* __restrict__ dst, int kt, int nt, bool remap, int lane) {
  const int n = nt * 64 + lane;
  const bool ok = n < N;
  const float* sp = src + (size_t)(kt * 64) * N + (ok ? n : 0);
  float v[64];
#pragma unroll
  for (int k = 0; k < 64; ++k) v[k] = __builtin_nontemporal_load(sp + (size_t)k * N);
  if (ok) {
    const int nn = remap ? remap_win(n) : n;
    u32x4* dp = (u32x4*)(dst + (size_t)nn * K + kt * 64);
#pragma unroll
    for (int q = 0; q < 8; ++q) {
      u32x4 w = {cvt2(v[8 * q], v[8 * q + 1]), cvt2(v[8 * q + 2], v[8 * q + 3]), cvt2(v[8 * q + 4], v[8 * q + 5]), cvt2(v[8 * q + 6], v[8 * q + 7])};
      dp[q] = w;
    }
  }
}

DI void phase0(const Params& p, char* smem) {
  const int tid = opaque_tid(), lane = tid & 63, wid = tid >> 6;
  const int gw = blockIdx.x * 8 + wid, nw = gridDim.x * 8;
  for (int it = gw; it < 792; it += nw) {
    int i = it;
    if (i < 528) { transpose_wave(p.w_in, 1024, 2072, p.wt_in, i / 33, i % 33, true, lane); continue; }
    i -= 528;
    if (i < 128) { transpose_wave(p.w1_k, 2048, 256, p.w1t_k, i / 4, i % 4, false, lane); continue; }
    i -= 128;
    if (i < 128) { transpose_wave(p.w1_v, 2048, 256, p.w1t_v, i / 4, i % 4, false, lane); continue; }
    i -= 128;
    if (i < 4) { transpose_wave(p.w2_k, 256, 64, p.w2t_k, i, 0, false, lane); continue; }
    i -= 4;
    transpose_wave(p.w2_v, 256, 64, p.w2t_v, i, 0, false, lane);
  }
  {
    unsigned* z = (unsigned*)(p.wt_in + (size_t)2072 * 1024);
    for (int i = blockIdx.x * 512 + tid; i < 104 * 512; i += gridDim.x * 512) z[i] = 0u;
    float* kz = p.kcf;
    for (int i = blockIdx.x * 512 + tid; i < 2 * 32 * 128 * 64; i += gridDim.x * 512) kz[i] = 0.f;
  }
  for (int row = gw * 2; row < NTOK; row += nw * 2) {
    float4 v[2][4];
#pragma unroll
    for (int r = 0; r < 2; ++r)
#pragma unroll
      for (int i = 0; i < 4; ++i) { f32x4 t = __builtin_nontemporal_load(((const f32x4*)(p.x + (size_t)(row + r) * 1024)) + lane + 64 * i); v[r][i] = float4{t[0], t[1], t[2], t[3]}; }
    float4 g[4];
#pragma unroll
    for (int i = 0; i < 4; ++i) g[i] = ((const float4*)p.g_mix_pre)[lane + 64 * i];
#pragma unroll
    for (int r = 0; r < 2; ++r) {
      float ss = 0.f;
#pragma unroll
      for (int i = 0; i < 4; ++i) ss += v[r][i].x * v[r][i].x + v[r][i].y * v[r][i].y + v[r][i].z * v[r][i].z + v[r][i].w * v[r][i].w;
      ss = wave_sum(ss);
      const float rs = rsqrtf(ss * (1.f / 1024.f) + EPS);
#pragma unroll
      for (int i = 0; i < 4; ++i)
        *(s16x4*)(p.a + (size_t)(row + r) * 1024 + (lane + 64 * i) * 4) =
            pack4(v[r][i].x * rs * g[i].x, v[r][i].y * rs * g[i].y, v[r][i].z * rs * g[i].z, v[r][i].w * rs * g[i].w);
    }
  }
}

DI void attn_tile64(const us (*Ks)[80], const us (*Vt)[80], const bf16x8 (&qf)[2][2], f32x4 (&o)[4][2], float (&M)[2], float (&l)[2],
                    const float (&sl2)[2], const float (&qs)[2], const f32x4 (&idxf)[4], int key0, int tok, int fr, int fq,
                    int mode, int window, bool sel) {
  bf16x8 kf[4][2];
#pragma unroll
  for (int mt = 0; mt < 4; ++mt)
#pragma unroll
    for (int ks = 0; ks < 2; ++ks) kf[mt][ks] = *(const bf16x8*)&Ks[mt * 16 + fr][ks * 32 + fq * 8];
  bf16x8 vf[4][2];
#pragma unroll
  for (int dt = 0; dt < 4; ++dt)
#pragma unroll
    for (int s2 = 0; s2 < 2; ++s2) {
      s16x4 lo = lds_tr4(&Vt[s2 * 32 + fq * 4 + (fr >> 2)][dt * 16 + (fr & 3) * 4]);
      s16x4 hi = lds_tr4(&Vt[s2 * 32 + 16 + fq * 4 + (fr >> 2)][dt * 16 + (fr & 3) * 4]);
      vf[dt][s2] = __builtin_shufflevector(lo, hi, 0, 1, 2, 3, 4, 5, 6, 7);
    }
  const float Df = (float)(tok - key0);
  const float thr = (mode == 2) ? Df - (float)window : Df;
#pragma unroll
  for (int nt = 0; nt < 2; ++nt) {
    const bf16x8 q0 = nt ? qf[1][0] : qf[0][0];
    const bf16x8 q1 = nt ? qf[1][1] : qf[0][1];
    const float sl = nt ? sl2[1] : sl2[0];
    const float qsn = nt ? qs[1] : qs[0];
    const float Mold = nt ? M[1] : M[0];
    f32x4 s[4];
    __builtin_amdgcn_s_setprio(1);
#pragma unroll
    for (int mt = 0; mt < 4; ++mt) {
      s[mt] = f32x4{0.f, 0.f, 0.f, 0.f};
      s[mt] = MFMA16(kf[mt][0], q0, s[mt]);
      s[mt] = MFMA16(kf[mt][1], q1, s[mt]);
    }
    __builtin_amdgcn_s_setprio(0);
#pragma unroll
    for (int mt = 0; mt < 4; ++mt) s[mt] = s[mt] * qsn + idxf[mt];
    if (mode == 1) {
#pragma unroll
      for (int mt = 0; mt < 4; ++mt)
#pragma unroll
        for (int j = 0; j < 4; ++j) s[mt][j] = (idxf[mt][j] <= thr) ? s[mt][j] : NEG_INF;
    } else if (mode == 2) {
#pragma unroll
      for (int mt = 0; mt < 4; ++mt)
#pragma unroll
        for (int j = 0; j < 4; ++j) s[mt][j] = (idxf[mt][j] > thr) ? s[mt][j] : NEG_INF;
    }
    float mx = fmaxf(fmaxf(s[0][0], s[0][1]), fmaxf(s[0][2], s[0][3]));
#pragma unroll
    for (int mt = 1; mt < 4; ++mt) mx = fmaxf(fmaxf(mx, s[mt][0]), fmaxf(fmaxf(s[mt][1], s[mt][2]), s[mt][3]));
    mx = xor16_max(mx);
    mx = xor32_max(mx);
    mx = sel ? mx - Df : NEG_INF;
    const float Mnew = fmaxf(Mold, mx);
    const float Muse = (Mnew == NEG_INF) ? 0.f : Mnew;
    const float alpha = ex2(sl * (Mold - Muse));
    const float c = sel ? -sl * (Df + Muse) : NEG_INF;
    float ps = 0.f;
#pragma unroll
    for (int mt = 0; mt < 4; ++mt) {
      s[mt] = s[mt] * sl + c;
#pragma unroll
      for (int j = 0; j < 4; ++j) s[mt][j] = ex2(s[mt][j]);
    }
    {
      f32x4 t = (s[0] + s[1]) + (s[2] + s[3]);
      ps = (t[0] + t[1]) + (t[2] + t[3]);
    }
    bf16x8 pb[2];
#pragma unroll
    for (int s2 = 0; s2 < 2; ++s2) {
      s16x4 lo = pack4(s[2 * s2][0], s[2 * s2][1], s[2 * s2][2], s[2 * s2][3]);
      s16x4 hi = pack4(s[2 * s2 + 1][0], s[2 * s2 + 1][1], s[2 * s2 + 1][2], s[2 * s2 + 1][3]);
      pb[s2] = __builtin_shufflevector(lo, hi, 0, 1, 2, 3, 4, 5, 6, 7);
    }
    const bool resc = __ballot(alpha != 1.f) != 0ull;
    if (nt == 0) {
      M[0] = Mnew; l[0] = l[0] * alpha + ps;
      if (resc) {
#pragma unroll
        for (int dt = 0; dt < 4; ++dt) o[dt][0] *= alpha;
      }
      __builtin_amdgcn_s_setprio(1);
#pragma unroll
      for (int dt = 0; dt < 4; ++dt)
#pragma unroll
        for (int s2 = 0; s2 < 2; ++s2) o[dt][0] = MFMA16(vf[dt][s2], pb[s2], o[dt][0]);
      __builtin_amdgcn_s_setprio(0);
    } else {
      M[1] = Mnew; l[1] = l[1] * alpha + ps;
      if (resc) {
#pragma unroll
        for (int dt = 0; dt < 4; ++dt) o[dt][1] *= alpha;
      }
      __builtin_amdgcn_s_setprio(1);
#pragma unroll
      for (int dt = 0; dt < 4; ++dt)
#pragma unroll
        for (int s2 = 0; s2 < 2; ++s2) o[dt][1] = MFMA16(vf[dt][s2], pb[s2], o[dt][1]);
      __builtin_amdgcn_s_setprio(0);
    }
  }
}

DI void load_kv64(const us* __restrict__ projb, int key0, int kcol, int vcol, int tid, bf16x8& kr, bf16x8& vr) {
  const us* rp = projb + (size_t)(key0 + (tid >> 3)) * LDP + (tid & 7) * 8;
  kr = *(const bf16x8*)(rp + kcol);
  vr = *(const bf16x8*)(rp + vcol);
}
DI void store_kv64(us (*Ks)[80], us (*Vt)[80], int tid, const bf16x8& kr, const bf16x8& vr) {
  *(bf16x8*)&Ks[tid >> 3][(tid & 7) * 8] = kr;
  *(bf16x8*)&Vt[tid >> 3][(tid & 7) * 8] = vr;
}

DI void banded_item(const Params& p, int b, int g, int tq, int kind, char* smem) {
  us(*Ks)[80] = (us(*)[80])smem;
  us(*Vt)[80] = (us(*)[80])(smem + 2 * 64 * 80 * 2);
  const int tid = opaque_tid(), lane = tid & 63, w = tid >> 6, fr = lane & 15, fq = lane >> 4;
  const int tg = w >> 1, hp = w & 1;
  const int t0 = tq * 64, tok = t0 + 16 * tg + fr;
  const int qcol = kind ? C_QS : C_QN, kcol = (kind ? C_KSW : C_KW) + g * 64, vcol = (kind ? C_VSW : C_VW) + g * 64;
  const int window = kind ? 128 : 512;
  const us* projb = p.proj + (size_t)b * T * LDP;
  bf16x8 qf[2][2];
  f32x4 o[4][2];
  float m[2], l[2], slope2[2], qs[2];
  f32x4 idxf[4];
#pragma unroll
  for (int mt = 0; mt < 4; ++mt)
#pragma unroll
    for (int j = 0; j < 4; ++j) idxf[mt][j] = (float)(mt * 16 + fq * 4 + j);
#pragma unroll
  for (int r = 0; r < 2; ++r) {
    int hh = g * 4 + hp * 2 + r;
#pragma unroll
    for (int ks = 0; ks < 2; ++ks) qf[r][ks] = __builtin_nontemporal_load((const bf16x8*)(projb + (size_t)tok * LDP + qcol + hh * 64 + ks * 32 + fq * 8));
    float sl = kind ? exp2f(-(float)(hh + 1)) : exp2f(-0.5f * (float)(2 * hh + 1));
    slope2[r] = sl * LOG2E;
    qs[r] = SC2 / slope2[r];
    if (kind) { m[r] = p.sinks[hh] * LOG2E / slope2[r]; l[r] = (fq == 0) ? 1.f : 0.f; }
    else { m[r] = NEG_INF; l[r] = 0.f; }
#pragma unroll
    for (int dt = 0; dt < 4; ++dt) o[dt][r] = f32x4{0.f, 0.f, 0.f, 0.f};
  }
  int kt0 = t0 - window; if (kt0 < 0) kt0 = 0; kt0 >>= 6;
  {
    bf16x8 kr, vr;
    load_kv64(projb, tq * 64, kcol, vcol, tid, kr, vr);
    __syncthreads();
    store_kv64(Ks, Vt, tid, kr, vr);
    __syncthreads();
    int cur = 0;
    for (int kt = tq; kt >= kt0; --kt) {
      const bool more = kt > kt0;
      if (more) load_kv64(projb, (kt - 1) * 64, kcol, vcol, tid, kr, vr);
      const int mode = (kt == tq) ? 1 : ((64 * (tq - kt) + 63 >= window) ? 2 : 0);
      attn_tile64(Ks + cur * 64, Vt + cur * 64, qf, o, m, l, slope2, qs, idxf, kt * 64, tok, fr, fq, mode, window, true);
      if (more) store_kv64(Ks + (cur ^ 1) * 64, Vt + (cur ^ 1) * 64, tid, kr, vr);
      __syncthreads();
      cur ^= 1;
    }
  }
  const size_t rowg = (size_t)b * T + tok;
#pragma unroll
  for (int r = 0; r < 2; ++r) {
    float lt = l[r]; lt = xor16_sum(lt); lt = xor32_sum(lt);
    float inv = lt > 0.f ? 1.f / lt : 0.f;
    int hh = g * 4 + hp * 2 + r;
    if (!kind) inv *= p.gates[rowg * 24 + hh * 3 + 2];
    us* dst = p.attn + rowg * 1024 + (kind ? 512 : 0) + hh * 64 + fq * 4;
#pragma unroll
    for (int dt = 0; dt < 4; ++dt) *(s16x4*)(dst + dt * 16) = pack4(o[dt][r][0] * inv, o[dt][r][1] * inv, o[dt][r][2] * inv, o[dt][r][3] * inv);
  }
}

DI void compress_item(const Params& p, int item, char* smem) {
  const int mh = item & 1, nh = (item >> 1) & 1, g = (item >> 2) & 1, b = (item >> 3) & 15, kv = item >> 7;
  const us* base = p.proj + (size_t)b * T * LDP + (kv ? C_VC : C_KC) + g * 64;
  ALoadCmp al{base, kv ? p.pe_v : p.pe_k, mh * 64};
  const us* w1t = kv ? p.w1t_v : p.w1t_k;
  const us* w2t = kv ? p.w2t_v : p.w2t_k;
  float* dst = (kv ? p.vcf : p.kcf) + (size_t)(b * 2 + g) * 128 * 64 + (size_t)mh * 64 * 64;
  us* Hs = (us*)smem;
  us* Ws = (us*)(smem + 64 * 136 * 2);
  const int tid = opaque_tid(), lane = tid & 63, w = tid >> 6, fr = lane & 15, fq = lane >> 4;
  EpiGeluLds epi{Hs};
  gemm_tile<1>(al, w1t, 2048, nh * 128, 32, epi, smem);
#pragma unroll
  for (int i = 0; i < 2; ++i) {
    int c = tid + 512 * i, r = c >> 4, ch = c & 15;
    *(bf16x8*)(Ws + r * 136 + ch * 8) = *(const bf16x8*)(w2t + (size_t)r * 256 + nh * 128 + ch * 8);
  }
  __syncthreads();
  const int mrow = (w & 3) * 16, n0 = (w >> 2) * 2;
  f32x4 acc[2];
#pragma unroll
  for (int n = 0; n < 2; ++n) acc[n] = f32x4{0.f, 0.f, 0.f, 0.f};
#pragma unroll
  for (int ks = 0; ks < 4; ++ks) {
    bf16x8 af = *(const bf16x8*)(Hs + (mrow + fr) * 136 + ks * 32 + fq * 8);
#pragma unroll
    for (int n = 0; n < 2; ++n) {
      bf16x8 bfr = *(const bf16x8*)(Ws + ((n0 + n) * 16 + fr) * 136 + ks * 32 + fq * 8);
      acc[n] = MFMA16(bfr, af, acc[n]);
    }
  }
#pragma unroll
  for (int n = 0; n < 2; ++n) {
    float* d = dst + (size_t)(mrow + fr) * 64 + (n0 + n) * 16 + fq * 4;
#pragma unroll
    for (int j = 0; j < 4; ++j) atomicAdd(d + j, acc[n][j]);
  }
  __syncthreads();
}

DI void cmp_probs(const us* KcS, const bf16x8 (&qfn)[2], float slope2, int tok, int fr, int fq, int npair, f32x4 (&s)[8]) {
  float mx = NEG_INF;
#pragma unroll
  for (int pr = 0; pr < 4; ++pr) {
    if (pr < npair) {
#pragma unroll
      for (int h = 0; h < 2; ++h) {
        const int mt = pr * 2 + h;
        s[mt] = f32x4{0.f, 0.f, 0.f, 0.f};
#pragma unroll
        for (int ks = 0; ks < 2; ++ks) {
          bf16x8 kf = *(const bf16x8*)(KcS + (mt * 16 + fr) * 80 + ks * 32 + fq * 8);
          s[mt] = MFMA16(kf, qfn[ks], s[mt]);
        }
      }
#pragma unroll
      for (int h = 0; h < 2; ++h) {
        const int mt = pr * 2 + h;
#pragma unroll
        for (int j = 0; j < 4; ++j) {
          int n = mt * 16 + fq * 4 + j;
          int dist = tok - (16 * n + 31);
          float v = dist >= 0 ? (s[mt][j] * SC2 - slope2 * (float)dist) : NEG_INF;
          s[mt][j] = v;
          mx = fmaxf(mx, v);
        }
      }
    }
  }
  mx = xor16_max(mx);
  mx = xor32_max(mx);
  float muse = (mx == NEG_INF) ? 0.f : mx;
  float ps = 0.f;
#pragma unroll
  for (int pr = 0; pr < 4; ++pr) {
    if (pr < npair) {
#pragma unroll
      for (int h = 0; h < 2; ++h)
#pragma unroll
        for (int j = 0; j < 4; ++j) { float pv = ex2(s[pr * 2 + h][j] - muse); s[pr * 2 + h][j] = pv; ps += pv; }
    } else {
      s[pr * 2] = f32x4{0.f, 0.f, 0.f, 0.f}; s[pr * 2 + 1] = f32x4{0.f, 0.f, 0.f, 0.f};
    }
  }
  ps = xor16_sum(ps);
  ps = xor32_sum(ps);
  float inv = ps > 0.f ? 1.f / ps : 0.f;
#pragma unroll
  for (int mt = 0; mt < 8; ++mt) s[mt] *= inv;
}

DI void nsa_item(const Params& p, int b, int g, int tq, char* smem) {
  us* KcS = (us*)smem;
  us* VcT = (us*)(smem + 20480);
  us(*Ks)[80] = (us(*)[80])(smem + 40960);
  us(*Vt)[80] = (us(*)[80])(smem + 61440);
  float* impS = (float*)(smem + 81920);
  float* impL = (float*)(smem + 98816);
  unsigned* unionS = (unsigned*)(smem + 115712);
  u32x4* ocS = (u32x4*)smem;
  const int tid = opaque_tid(), lane = tid & 63, w = tid >> 6, fr = lane & 15, fq = lane >> 4;
  const int tg = w >> 1, hp = w & 1;
  const int t0 = tq * 64, tok = t0 + 16 * tg + fr;
  const us* projb = p.proj + (size_t)b * T * LDP;
  const float* kcf = p.kcf + (size_t)(b * 2 + g) * 128 * 64;
  const float* vcf = p.vcf + (size_t)(b * 2 + g) * 128 * 64;
  const size_t rowg = (size_t)b * T + tok;
  int npair = ((tq * 4 + 2) >> 5) + 1; if (npair > 4) npair = 4;
  const int nrows = npair * 32;
  __syncthreads();
#pragma unroll
  for (int i = 0; i < 2; ++i) {
    int c = tid + 512 * i, r = c >> 3, ch = c & 7;
    if (r >= nrows) continue;
    const float4* s4 = (const float4*)(kcf + r * 64 + ch * 8);
    float4 a0 = s4[0], a1 = s4[1];
    s16x4 lo = pack4(a0.x, a0.y, a0.z, a0.w), hi = pack4(a1.x, a1.y, a1.z, a1.w);
    *(bf16x8*)(KcS + r * 80 + ch * 8) = __builtin_shufflevector(lo, hi, 0, 1, 2, 3, 4, 5, 6, 7);
  }
#pragma unroll
  for (int i = 0; i < 2; ++i) {
    int c = tid + 512 * i, r = c >> 3, ch = c & 7;
    if (r >= nrows) continue;
    const float4* s4 = (const float4*)(vcf + r * 64 + ch * 8);
    float4 a0 = s4[0], a1 = s4[1];
    s16x4 lo = pack4(a0.x, a0.y, a0.z, a0.w), hi = pack4(a1.x, a1.y, a1.z, a1.w);
    *(bf16x8*)(VcT + r * 80 + ch * 8) = __builtin_shufflevector(lo, hi, 0, 1, 2, 3, 4, 5, 6, 7);
  }
  if (tid == 0) *unionS = 0u;
  bf16x8 qf[2][2];
  float slope2[2];
#pragma unroll
  for (int r = 0; r < 2; ++r) {
    int hh = g * 4 + hp * 2 + r;
#pragma unroll
    for (int ks = 0; ks < 2; ++ks) qf[r][ks] = __builtin_nontemporal_load((const bf16x8*)(projb + (size_t)tok * LDP + C_QN + hh * 64 + ks * 32 + fq * 8));
    slope2[r] = exp2f(-0.5f * (float)(2 * hh + 1)) * LOG2E;
  }
  __syncthreads();
  u32x4 ocp[4];
  {
    float accA[8], accL[8];
#pragma unroll
    for (int mt = 0; mt < 8; ++mt) { accA[mt] = 0.f; accL[mt] = 0.f; }
#pragma unroll 1
    for (int nt = 0; nt < 2; ++nt) {
      bf16x8 qn[2];
      qn[0] = nt ? qf[1][0] : qf[0][0];
      qn[1] = nt ? qf[1][1] : qf[0][1];
      f32x4 s[8];
      int frz = fr, fqz = fq, tokz = tok;
      asm volatile("" : "+v"(frz), "+v"(fqz), "+v"(tokz));
      cmp_probs(KcS, qn, nt ? slope2[1] : slope2[0], tokz, frz, fqz, npair, s);
#pragma unroll
      for (int mt = 0; mt < 8; ++mt) {
        accA[mt] += (s[mt][0] + s[mt][1]) + (s[mt][2] + s[mt][3]);
        accL[mt] += s[mt][3];
      }
      const float g0 = p.gates[rowg * 24 + (g * 4 + hp * 2 + nt) * 3 + 0];
      f32x4 tmp[4];
#pragma unroll
      for (int dt = 0; dt < 4; ++dt) tmp[dt] = f32x4{0.f, 0.f, 0.f, 0.f};
#pragma unroll
      for (int s2 = 0; s2 < 4; ++s2) {
        if (s2 >= npair) continue;
        s16x4 lo = pack4(s[2 * s2][0], s[2 * s2][1], s[2 * s2][2], s[2 * s2][3]);
        s16x4 hi = pack4(s[2 * s2 + 1][0], s[2 * s2 + 1][1], s[2 * s2 + 1][2], s[2 * s2 + 1][3]);
        bf16x8 pb = __builtin_shufflevector(lo, hi, 0, 1, 2, 3, 4, 5, 6, 7);
#pragma unroll
        for (int dt = 0; dt < 4; ++dt) {
          s16x4 vlo = lds_tr4(VcT + (s2 * 32 + fqz * 4 + (frz >> 2)) * 80 + dt * 16 + (frz & 3) * 4);
          s16x4 vhi = lds_tr4(VcT + (s2 * 32 + 16 + fqz * 4 + (frz >> 2)) * 80 + dt * 16 + (frz & 3) * 4);
          bf16x8 vf = __builtin_shufflevector(vlo, vhi, 0, 1, 2, 3, 4, 5, 6, 7);
          tmp[dt] = MFMA16(vf, pb, tmp[dt]);
        }
      }
      u32x4 lo4 = {cvt2(tmp[0][0] * g0, tmp[0][1] * g0), cvt2(tmp[0][2] * g0, tmp[0][3] * g0), cvt2(tmp[1][0] * g0, tmp[1][1] * g0), cvt2(tmp[1][2] * g0, tmp[1][3] * g0)};
      u32x4 hi4 = {cvt2(tmp[2][0] * g0, tmp[2][1] * g0), cvt2(tmp[2][2] * g0, tmp[2][3] * g0), cvt2(tmp[3][0] * g0, tmp[3][1] * g0), cvt2(tmp[3][2] * g0, tmp[3][3] * g0)};
      if (nt == 0) { ocp[0] = lo4; ocp[1] = hi4; } else { ocp[2] = lo4; ocp[3] = hi4; }
    }
    float* ia = impS + (hp * 64 + tg * 16 + fr) * 33;
    float* il = impL + (hp * 64 + tg * 16 + fr) * 33;
#pragma unroll
    for (int mt = 0; mt < 8; ++mt) {
      const int j = mt * 4 + fq;
      ia[j] = accA[mt];
      if (j < 31) il[j + 1] = accL[mt]; else il[0] = 0.f;
    }
  }
  __syncthreads();
#pragma unroll
  for (int q = 0; q < 4; ++q) ocS[q * 512 + tid] = ocp[q];
  unsigned sel;
  {
    const unsigned valid = (tq == 31) ? 0xffffffffu : ((1u << (tq + 1)) - 1u);
    unsigned forced = 1u | (1u << tq);
    if (tq > 0) forced |= 1u << (tq - 1);
    sel = forced & valid;
    int cnt = __popc(sel);
    float cand[8];
    {
      const float* a0 = impS + (tg * 16 + fr) * 33, *a1 = impS + (64 + tg * 16 + fr) * 33;
      const float* l0 = impL + (tg * 16 + fr) * 33, *l1 = impL + (64 + tg * 16 + fr) * 33;
#pragma unroll
      for (int mt = 0; mt < 8; ++mt) { const int j = mt * 4 + fq; cand[mt] = (a0[j] + a1[j]) + (l0[j] + l1[j]); }
    }
    for (int round = 0; round < 8; ++round) {
      if (cnt < 8) {
        const unsigned open = valid & ~sel;
        float bv = -1.f; int bj = 64;
#pragma unroll
        for (int mt = 0; mt < 8; ++mt) {
          const int j = mt * 4 + fq;
          if (((open >> j) & 1u) && cand[mt] > bv) { bv = cand[mt]; bj = j; }
        }
#pragma unroll
        for (int step = 0; step < 2; ++step) {
          const unsigned uv = __float_as_uint(bv), uj = (unsigned)bj;
          float v0, v1; int j0, j1;
          if (step == 0) {
            auto rv = __builtin_amdgcn_permlane16_swap(uv, uv, false, false); auto rj = __builtin_amdgcn_permlane16_swap(uj, uj, false, false);
            v0 = __uint_as_float(rv[0]); v1 = __uint_as_float(rv[1]); j0 = (int)rj[0]; j1 = (int)rj[1];
          } else {
            auto rv = __builtin_amdgcn_permlane32_swap(uv, uv, false, false); auto rj = __builtin_amdgcn_permlane32_swap(uj, uj, false, false);
            v0 = __uint_as_float(rv[0]); v1 = __uint_as_float(rv[1]); j0 = (int)rj[0]; j1 = (int)rj[1];
          }
          const bool take1 = (v1 > v0) || (v1 == v0 && j1 < j0);
          bv = take1 ? v1 : v0; bj = take1 ? j1 : j0;
        }
        if (bj < 32) { sel |= 1u << bj; cnt++; }
      }
    }
  }
  atomicOr(unionS, sel);
  f32x4 o[4][2];
  float m[2], l[2], qs[2];
  f32x4 idxf[4];
#pragma unroll
  for (int mt = 0; mt < 4; ++mt)
#pragma unroll
    for (int j = 0; j < 4; ++j) idxf[mt][j] = (float)(mt * 16 + fq * 4 + j);
#pragma unroll
  for (int r = 0; r < 2; ++r) {
    qs[r] = SC2 / slope2[r];
    m[r] = NEG_INF; l[r] = 0.f;
#pragma unroll
    for (int dt = 0; dt < 4; ++dt) o[dt][r] = f32x4{0.f, 0.f, 0.f, 0.f};
  }
  {
    const int kcol = C_KW + g * 64, vcol = C_VW + g * 64;
    int kt0 = t0 - 512; if (kt0 < 0) kt0 = 0; kt0 >>= 6;
    bf16x8 kr, vr;
    load_kv64(projb, tq * 64, kcol, vcol, tid, kr, vr);
    store_kv64(Ks, Vt, tid, kr, vr);
    __syncthreads();
    int cur = 0;
    for (int kt = tq; kt >= kt0; --kt) {
      const bool more = kt > kt0;
      if (more) load_kv64(projb, (kt - 1) * 64, kcol, vcol, tid, kr, vr);
      const int mode = (kt == tq) ? 1 : ((64 * (tq - kt) + 63 >= 512) ? 2 : 0);
      attn_tile64(Ks + cur * 64, Vt + cur * 64, qf, o, m, l, slope2, qs, idxf, kt * 64, tok, fr, fq, mode, 512, true);
      if (more) store_kv64(Ks + (cur ^ 1) * 64, Vt + (cur ^ 1) * 64, tid, kr, vr);
      __syncthreads();
      cur ^= 1;
    }
#pragma unroll
    for (int r = 0; r < 2; ++r) {
      float lt = l[r]; lt = xor16_sum(lt); lt = xor32_sum(lt);
      const float sc = (lt > 0.f ? 1.f / lt : 0.f) * p.gates[rowg * 24 + (g * 4 + hp * 2 + r) * 3 + 2];
#pragma unroll
      for (int half = 0; half < 2; ++half) {
        u32x4 oc = ocS[(r * 2 + half) * 512 + tid];
#pragma unroll
        for (int d2 = 0; d2 < 2; ++d2) {
          const int dt = half * 2 + d2;
          const unsigned c01 = oc[d2 * 2], c23 = oc[d2 * 2 + 1];
          oc[d2 * 2] = cvt2(o[dt][r][0] * sc + bf2f((us)(c01 & 0xffffu)), o[dt][r][1] * sc + bf2f((us)(c01 >> 16)));
          oc[d2 * 2 + 1] = cvt2(o[dt][r][2] * sc + bf2f((us)(c23 & 0xffffu)), o[dt][r][3] * sc + bf2f((us)(c23 >> 16)));
        }
        ocS[(r * 2 + half) * 512 + tid] = oc;
      }
      m[r] = NEG_INF; l[r] = 0.f;
#pragma unroll
      for (int dt = 0; dt < 4; ++dt) o[dt][r] = f32x4{0.f, 0.f, 0.f, 0.f};
    }
  }
  const unsigned uni = *unionS;
  {
    unsigned rem = uni;
    int j = 31 - __clz(rem); rem &= ~(1u << j);
    bf16x8 kr, vr;
    load_kv64(projb, j * 64, C_KS + g * 64, C_VS + g * 64, tid, kr, vr);
    store_kv64(Ks, Vt, tid, kr, vr);
    __syncthreads();
    int cur = 0;
    while (true) {
      const bool more = rem != 0u;
      const int jn = more ? (31 - __clz(rem)) : 0;
      if (more) rem &= ~(1u << jn);
      if (more) load_kv64(projb, jn * 64, C_KS + g * 64, C_VS + g * 64, tid, kr, vr);
      {
        const bool selj = ((sel >> j) & 1u) != 0;
        if (__ballot(selj) != 0ull)
          attn_tile64(Ks + cur * 64, Vt + cur * 64, qf, o, m, l, slope2, qs, idxf, j * 64, tok, fr, fq, (j == tq) ? 1 : 0, 0, selj);
      }
      if (more) store_kv64(Ks + (cur ^ 1) * 64, Vt + (cur ^ 1) * 64, tid, kr, vr);
      __syncthreads();
      if (!more) break;
      cur ^= 1; j = jn;
    }
  }
#pragma unroll
  for (int r = 0; r < 2; ++r) {
    float lt = l[r]; lt = xor16_sum(lt); lt = xor32_sum(lt);
    const float sc = (lt > 0.f ? 1.f / lt : 0.f) * p.gates[rowg * 24 + (g * 4 + hp * 2 + r) * 3 + 1];
    us* dst = p.attn + rowg * 1024 + (g * 4 + hp * 2 + r) * 64 + fq * 4;
#pragma unroll
    for (int half = 0; half < 2; ++half) {
      const u32x4 oc = ocS[(r * 2 + half) * 512 + tid];
#pragma unroll
      for (int d2 = 0; d2 < 2; ++d2) {
        const int dt = half * 2 + d2;
        const unsigned c01 = oc[d2 * 2], c23 = oc[d2 * 2 + 1];
        *(s16x4*)(dst + dt * 16) = pack4(o[dt][r][0] * sc + bf2f((us)(c01 & 0xffffu)), o[dt][r][1] * sc + bf2f((us)(c01 >> 16)),
                                         o[dt][r][2] * sc + bf2f((us)(c23 & 0xffffu)), o[dt][r][3] * sc + bf2f((us)(c23 >> 16)));
      }
    }
  }
}

DI void phase5(const Params& p) {
  const int tid = opaque_tid(), lane = tid & 63, wid = tid >> 6;
  const us* mix = p.a; us* mbuf = p.attn;
  for (int row = (blockIdx.x * 8 + wid) * 2; row < NTOK; row += gridDim.x * 16) {
    s16x4 mt[2][4]; float4 xv[2][4];
#pragma unroll
    for (int r = 0; r < 2; ++r)
#pragma unroll
      for (int i = 0; i < 4; ++i) {
        mt[r][i] = __builtin_nontemporal_load((const s16x4*)(mix + (size_t)(row + r) * 1024 + (lane + 64 * i) * 4));
        { f32x4 t = __builtin_nontemporal_load(((const f32x4*)(p.x + (size_t)(row + r) * 1024)) + lane + 64 * i); xv[r][i] = float4{t[0], t[1], t[2], t[3]}; }
      }
#pragma unroll
    for (int r = 0; r < 2; ++r) {
      float mv[4][4]; float ss = 0.f;
#pragma unroll
      for (int i = 0; i < 4; ++i)
#pragma unroll
        for (int j = 0; j < 4; ++j) { mv[i][j] = bf2f((us)mt[r][i][j]); ss += mv[i][j] * mv[i][j]; }
      ss = wave_sum(ss);
      const float r1 = rsqrtf(ss * (1.f / 1024.f) + EPS);
      float hv[4][4]; float ss2 = 0.f;
#pragma unroll
      for (int i = 0; i < 4; ++i) {
        float4 g = ((const float4*)p.g_mix_post)[lane + 64 * i];
        hv[i][0] = xv[r][i].x + mv[i][0] * r1 * g.x; hv[i][1] = xv[r][i].y + mv[i][1] * r1 * g.y;
        hv[i][2] = xv[r][i].z + mv[i][2] * r1 * g.z; hv[i][3] = xv[r][i].w + mv[i][3] * r1 * g.w;
#pragma unroll
        for (int j = 0; j < 4; ++j) ss2 += hv[i][j] * hv[i][j];
      }
      ss2 = wave_sum(ss2);
      const float r2 = rsqrtf(ss2 * (1.f / 1024.f) + EPS);
#pragma unroll
      for (int i = 0; i < 4; ++i) {
        float4 g = ((const float4*)p.g_mlp_pre)[lane + 64 * i];
        *(s16x4*)(mbuf + (size_t)(row + r) * 1024 + (lane + 64 * i) * 4) = pack4(hv[i][0] * r2 * g.x, hv[i][1] * r2 * g.y, hv[i][2] * r2 * g.z, hv[i][3] * r2 * g.w);
      }
    }
  }
}
DI void phase8(const Params& p) {
  const int tid = opaque_tid(), lane = tid & 63, wid = tid >> 6;
  const us* mix = p.a; const us* dn = p.attn;
  for (int row = (blockIdx.x * 8 + wid) * 2; row < NTOK; row += gridDim.x * 16) {
    s16x4 mt[2][4], dt[2][4]; float4 xv[2][4];
#pragma unroll
    for (int r = 0; r < 2; ++r)
#pragma unroll
      for (int i = 0; i < 4; ++i) {
        mt[r][i] = __builtin_nontemporal_load((const s16x4*)(mix + (size_t)(row + r) * 1024 + (lane + 64 * i) * 4));
        dt[r][i] = __builtin_nontemporal_load((const s16x4*)(dn + (size_t)(row + r) * 1024 + (lane + 64 * i) * 4));
        { f32x4 t = __builtin_nontemporal_load(((const f32x4*)(p.x + (size_t)(row + r) * 1024)) + lane + 64 * i); xv[r][i] = float4{t[0], t[1], t[2], t[3]}; }
      }
#pragma unroll
    for (int r = 0; r < 2; ++r) {
      float ss = 0.f, sd = 0.f;
#pragma unroll
      for (int i = 0; i < 4; ++i)
#pragma unroll
        for (int j = 0; j < 4; ++j) { float a = bf2f((us)mt[r][i][j]), b = bf2f((us)dt[r][i][j]); ss += a * a; sd += b * b; }
      ss = wave_sum(ss); sd = wave_sum(sd);
      const float r1 = rsqrtf(ss * (1.f / 1024.f) + EPS), r3 = rsqrtf(sd * (1.f / 1024.f) + EPS);
#pragma unroll
      for (int i = 0; i < 4; ++i) {
        float4 g1 = ((const float4*)p.g_mix_post)[lane + 64 * i];
        float4 g4 = ((const float4*)p.g_mlp_post)[lane + 64 * i];
        float4 h = xv[r][i];
        h.x = (h.x + bf2f((us)mt[r][i][0]) * r1 * g1.x) + bf2f((us)dt[r][i][0]) * r3 * g4.x;
        h.y = (h.y + bf2f((us)mt[r][i][1]) * r1 * g1.y) + bf2f((us)dt[r][i][1]) * r3 * g4.y;
        h.z = (h.z + bf2f((us)mt[r][i][2]) * r1 * g1.z) + bf2f((us)dt[r][i][2]) * r3 * g4.z;
        h.w = (h.w + bf2f((us)mt[r][i][3]) * r1 * g1.w) + bf2f((us)dt[r][i][3]) * r3 * g4.w;
        __builtin_nontemporal_store(f32x4{h.x, h.y, h.z, h.w}, ((f32x4*)(p.out + (size_t)(row + r) * 1024)) + lane + 64 * i);
      }
    }
  }
}

DI void late_weights_item(const Params& p, int item) {
  const int tid = opaque_tid(), lane = tid & 63, wid = tid >> 6;
  int i = item * 8 + wid;
  if (i < 256) { transpose_wave(p.w_out, 1024, 1024, p.wt_out, i / 16, i % 16, false, lane); return; }
  i -= 256;
  if (i < 1024) { transpose_wave(p.w_up, 1024, 4096, p.wt_up, i / 64, i % 64, false, lane); return; }
  i -= 1024;
  transpose_wave(p.w_down, 4096, 1024, p.wt_dn, i / 16, i % 16, false, lane);
}

DI void gates_rows(const Params& p, int row0, char* smem) {
  const int tid = opaque_tid(), lane = tid & 63, w = tid >> 6, fr = lane & 15, fq = lane >> 4;
  us* Bs = (us*)smem;
  __syncthreads();
#pragma unroll
  for (int i = 0; i < 8; ++i) {
    int c = tid + 512 * i, r = c >> 7, ch = c & 127;
    *(bf16x8*)(Bs + r * 1032 + ch * 8) = *(const bf16x8*)(p.wt_in + (size_t)(2048 + r) * 1024 + ch * 8);
  }
  __syncthreads();
  const us* ap = p.a + (size_t)(row0 + w * 16 + fr) * 1024 + fq * 8;
  const us* bp = Bs + fr * 1032 + fq * 8;
  f32x4 acc[2] = {f32x4{0.f, 0.f, 0.f, 0.f}, f32x4{0.f, 0.f, 0.f, 0.f}};
#pragma unroll 8
  for (int ks = 0; ks < 32; ++ks) {
    bf16x8 af = *(const bf16x8*)(ap + ks * 32);
    bf16x8 b0 = *(const bf16x8*)(bp + ks * 32);
    bf16x8 b1 = *(const bf16x8*)(bp + 16 * 1032 + ks * 32);
    acc[0] = MFMA16(b0, af, acc[0]);
    acc[1] = MFMA16(b1, af, acc[1]);
  }
  float* gp = p.gates + (size_t)(row0 + w * 16 + fr) * 24;
#pragma unroll
  for (int n = 0; n < 2; ++n) {
    if (n == 0 || fq < 2) {
      f32x4 o;
#pragma unroll
      for (int j = 0; j < 4; ++j) o[j] = 1.f / (1.f + __expf(-acc[n][j]));
      *(f32x4*)(gp + n * 16 + fq * 4) = o;
    }
  }
}

constexpr int LDS_BYTES = 131072 + 16;
__global__ void __launch_bounds__(512, 2) mega(Params p) {
  extern __shared__ __attribute__((aligned(16))) char smem[];
  cg::grid_group grid = cg::this_grid();
  if (p.phase_hi > NPH) grid.sync();
  volatile LAS unsigned* xst = (volatile LAS unsigned*)(smem + 131072);
  if (threadIdx.x < 4) xst[threadIdx.x] = 0u;
  __syncthreads();
  const XcdBarrier xb = xcd_barrier_post(p.bar, xst);
  for (int ph = p.phase_lo; ph < p.phase_hi; ++ph) {
    const bool is_gemm = (ph == 1) | (ph == 4) | (ph == 6) | (ph == 7);
    if (is_gemm) {
      const us* A = (ph == 1) ? p.a : (ph == 7 ? p.u : p.attn);
      const us* Bt = (ph == 1) ? p.wt_in : (ph == 4 ? p.wt_out : (ph == 6 ? p.wt_up : p.wt_dn));
      us* O = (ph == 1) ? p.proj : (ph == 6 ? p.u : (ph == 4 ? p.a : p.attn));
      const int N = (ph == 1) ? 2048 : (ph == 6 ? 4096 : 1024);
      const int K = (ph == 7) ? 4096 : 1024;
      const bool gates_first = (ph == 1) && (((blockIdx.x >> 3) & 1) != 0);
      if (gates_first) {
        for (int r0 = blockIdx.x * 128; r0 < NTOK; r0 += gridDim.x * 128) gates_rows(p, r0, smem);
        __syncthreads();
      }
      pg8::StaticOrder S; S.init(NTOK, N, (int)gridDim.x, (int)blockIdx.x);
      pg8::Gemm g{A, Bt, NTOK, N, K};
      EpiB16 E{O, N, ph == 6 ? 1 : 0};
      pg8::gemm_phase<EpiB16, pg8::StaticOrder, false>((PG8_LAS unsigned char*)smem, g, S, E, nullptr);
      if (ph == 1 && !gates_first)
        for (int r0 = blockIdx.x * 128; r0 < NTOK; r0 += gridDim.x * 128) gates_rows(p, r0, smem);
    } else if (ph == 0) {
      phase0(p, smem);
    } else if (ph == 2 || ph == 3) {
      volatile LAS int* qslot = (volatile LAS int*)(smem + 131072 + 8);
      unsigned* ctr = p.bar + 3584 + (ph - 2) * 64;
      const int nitems = (ph == 2) ? 256 : (1024 + 1024 + 288);
      int it = blockIdx.x;
      while (it < nitems) {
        int nx = 0;
        if (threadIdx.x == 0) nx = (int)gridDim.x + (int)atomicAdd(ctr, 1u);
        if (ph == 2) {
          compress_item(p, it, smem);
        } else if (it < 1024) {
          int g = 1 - (it >> 9), r9 = it & 511;
          nsa_item(p, r9 & 15, g, 31 - (r9 >> 4), smem);
        } else if (it < 2048) {
          int i = it - 1024;
          int tq = 31 - (i >> 5), rem = i & 31;
          banded_item(p, rem >> 1, rem & 1, tq, 1, smem);
        } else {
          late_weights_item(p, it - 2048);
        }
        if (threadIdx.x == 0) *qslot = nx;
        __syncthreads();
        it = *qslot;
        __syncthreads();
      }
    } else if (ph == 5) {
      phase5(p);
    } else {
      phase8(p);
    }
    if (ph + 1 < p.phase_hi) xcd_barrier(xb);
  }
}

extern "C" void kernel_launch(void* const* d_in, const int* in_sizes, int n_in, void* d_out, int out_size, void* d_ws, size_t ws_size,
                              hipStream_t stream) {
  static int grid_blocks = 0;
  if (!grid_blocks) {
    int dev = 0, cus = 0, per_cu = 0;
    (void)hipGetDevice(&dev);
    (void)hipDeviceGetAttribute(&cus, hipDeviceAttributeMultiprocessorCount, dev);
    (void)hipFuncSetAttribute((const void*)mega, hipFuncAttributeMaxDynamicSharedMemorySize, LDS_BYTES);
    (void)hipOccupancyMaxActiveBlocksPerMultiprocessor(&per_cu, (const void*)mega, 512, LDS_BYTES);
    if (per_cu < 1) per_cu = 1;
    if (per_cu > 1) per_cu = 1;
    grid_blocks = cus * per_cu;
  }
  Params p{};
  const float* const* in = (const float* const*)d_in;
  p.x = in[0]; p.g_mix_pre = in[1]; p.w_in = in[2]; p.pe_k = in[3]; p.w1_k = in[4]; p.w2_k = in[5]; p.pe_v = in[6]; p.w1_v = in[7];
  p.w2_v = in[8]; p.sinks = in[9]; p.w_out = in[10]; p.g_mix_post = in[11]; p.g_mlp_pre = in[12]; p.w_up = in[13]; p.w_down = in[14];
  p.g_mlp_post = in[15];
  p.out = (float*)d_out;
  char* ws = (char*)d_ws;
  const size_t MB = 1024 * 1024;
  p.a = (us*)(ws);
  p.attn = (us*)(ws + 64 * MB);
  p.proj = (us*)(ws + 128 * MB);
  p.u = (us*)(ws + 128 * MB);
  char* w = ws + 384 * MB;
  p.wt_in = (us*)w;  w += (size_t)2176 * 1024 * 2;
  p.wt_out = (us*)w; w += (size_t)1024 * 1024 * 2;
  p.wt_up = (us*)w;  w += (size_t)4096 * 1024 * 2;
  p.wt_dn = (us*)w;  w += (size_t)4096 * 1024 * 2;
  p.w1t_k = (us*)w;  w += (size_t)256 * 2048 * 2;
  p.w1t_v = (us*)w;  w += (size_t)256 * 2048 * 2;
  p.w2t_k = (us*)w;  w += (size_t)64 * 256 * 2;
  p.w2t_v = (us*)w;  w += (size_t)64 * 256 * 2;
  p.gates = (float*)w; w += (size_t)NTOK * 24 * 4;
  p.kcf = (float*)w; w += (size_t)32 * 128 * 64 * 4;
  p.vcf = (float*)w; w += (size_t)32 * 128 * 64 * 4;
  p.bar = (unsigned*)w; w += 16384;
  (void)hipMemsetAsync(p.bar, 0, 16384, stream);
  p.phase_lo = 0; p.phase_hi = NPH;
  void* args[] = {&p};
  hipError_t e = hipLaunchCooperativeKernel((const void*)mega, dim3(grid_blocks), dim3(512), args, LDS_BYTES, stream);
  if (e != hipSuccess) fprintf(stderr, "cooperative launch failed: %s (grid %d)\n", hipGetErrorString(e), grid_blocks);
}
```

```cpp
#include <hip/hip_runtime.h>
#include <hip/hip_cooperative_groups.h>
#include <cstdio>
namespace cg = cooperative_groups;

typedef unsigned short us;
typedef __attribute__((ext_vector_type(8))) short bf16x8;
typedef __attribute__((ext_vector_type(4))) short s16x4;
typedef __attribute__((ext_vector_type(4))) float f32x4;

#define DI __device__ __forceinline__
#define MFMA16(a, b, c) __builtin_amdgcn_mfma_f32_16x16x32_bf16((a), (b), (c), 0, 0, 0)

constexpr int T = 2048;
constexpr int NTOK = 32768;
constexpr int LDP = 2048;
constexpr int NPH = 9;
constexpr float LOG2E = 1.4426950408889634f;
constexpr float SC2 = 0.125f * 1.4426950408889634f;
constexpr float EPS = 1e-6f;
#define NEG_INF (-__builtin_inff())

constexpr int C_QN = 0, C_KC = 512, C_VC = 640, C_KS = 768, C_VS = 896, C_KW = 1024, C_VW = 1152, C_QS = 1280, C_KSW = 1792, C_VSW = 1920;

struct Params {
  const float *x, *g_mix_pre, *w_in, *pe_k, *w1_k, *w2_k, *pe_v, *w1_v, *w2_v, *sinks, *w_out, *g_mix_post, *g_mlp_pre, *w_up, *w_down, *g_mlp_post;
  float* out;
  us *wt_in, *wt_out, *wt_up, *wt_dn, *w1t_k, *w1t_v, *w2t_k, *w2t_v;
  us *a, *proj, *attn, *u;
  float *gates, *kcf, *vcf;
  unsigned* bar;
  int phase_lo, phase_hi;
};

DI us f2bf(float x) { unsigned u = __float_as_uint(x); u += 0x7fffu + ((u >> 16) & 1u); return (us)(u >> 16); }
DI float bf2f(us h) { return __uint_as_float(((unsigned)h) << 16); }
DI int opaque_tid() { int t = threadIdx.x; asm volatile("" : "+v"(t)); return t; }
DI float ex2(float x) { return __builtin_amdgcn_exp2f(x); }
DI float xor16_max(float x) { unsigned u = __float_as_uint(x); auto r = __builtin_amdgcn_permlane16_swap(u, u, false, false); return fmaxf(__uint_as_float(r[0]), __uint_as_float(r[1])); }
DI float xor32_max(float x) { unsigned u = __float_as_uint(x); auto r = __builtin_amdgcn_permlane32_swap(u, u, false, false); return fmaxf(__uint_as_float(r[0]), __uint_as_float(r[1])); }
DI float xor16_sum(float x) { unsigned u = __float_as_uint(x); auto r = __builtin_amdgcn_permlane16_swap(u, u, false, false); return __uint_as_float(r[0]) + __uint_as_float(r[1]); }
DI float xor32_sum(float x) { unsigned u = __float_as_uint(x); auto r = __builtin_amdgcn_permlane32_swap(u, u, false, false); return __uint_as_float(r[0]) + __uint_as_float(r[1]); }
DI s16x4 lds_tr4(const us* p) { return __builtin_amdgcn_ds_read_tr16_b64_v4i16((__attribute__((address_space(3))) s16x4*)p); }
DI float wave_sum(float v) {
#pragma unroll
  for (int o = 32; o >= 1; o >>= 1) v += __shfl_xor(v, o);
  return v;
}
typedef __bf16 bf2_t __attribute__((ext_vector_type(2)));
typedef float f2_t __attribute__((ext_vector_type(2)));
typedef unsigned u32x2 __attribute__((ext_vector_type(2)));
typedef unsigned u32x4 __attribute__((ext_vector_type(4)));
DI unsigned cvt2(float lo, float hi) { f2_t v = {lo, hi}; return __builtin_bit_cast(unsigned, __builtin_convertvector(v, bf2_t)); }
DI s16x4 pack4(float a, float b, float c, float d) { u32x2 r = {cvt2(a, b), cvt2(c, d)}; return __builtin_bit_cast(s16x4, r); }

#define XB_TMO      128
#define XB_XCNT(j)  (256  + 64 * (j))
#define XB_XSUB(j)  (1280 + 64 * (j))
#define XB_XGEN(j)  (2304 + 64 * (j))
#define XB_TOP      3328
#define XB_TOPGEN   3392
#define XCD_BAR_WORDS 3456
#define XB_SPIN_CAP (1u << 18)
#define LAS __attribute__((address_space(3)))

__device__ __forceinline__ unsigned xb_ld(unsigned* p)              { return __hip_atomic_load(p, __ATOMIC_RELAXED, __HIP_MEMORY_SCOPE_AGENT); }
__device__ __forceinline__ unsigned xb_add(unsigned* p, unsigned v) { return __hip_atomic_fetch_add(p, v, __ATOMIC_RELAXED, __HIP_MEMORY_SCOPE_AGENT); }
__device__ __forceinline__ unsigned xb_xcc_id() { return (unsigned)__builtin_amdgcn_s_getreg((3 << 11) | 20) & 0xFu; }
#define XB_SPIN(cond, bar) do { unsigned _sp = 0; while (cond) { __builtin_amdgcn_s_sleep(0); \
    if ((++_sp & 255u) == 0u) { if (xb_ld(&(bar)[XB_TMO])) break; if (_sp > XB_SPIN_CAP) { atomicAdd(&(bar)[XB_TMO], 1u); break; } } } } while (0)

struct XcdBarrier {
    unsigned* bar; unsigned x;
    volatile LAS unsigned* st;
};

__device__ __forceinline__ XcdBarrier xcd_barrier_post(unsigned* bar, volatile LAS unsigned* st) {
    XcdBarrier b; b.bar = bar; b.x = xb_xcc_id(); b.st = st;
    if (threadIdx.x == 0) (void)xb_add(&bar[XB_XCNT(b.x)], 1u);
    return b;
}
__device__ __forceinline__ void xcd_barrier_complete(unsigned* bar, unsigned x, unsigned& nloc, unsigned& nx) {
    const unsigned G = gridDim.x * gridDim.y * gridDim.z;
    unsigned sum, cnt, mine, sp = 0u;
    for (;;) {
        sum = 0u; cnt = 0u; mine = 0u;
#pragma unroll
        for (unsigned j = 0; j < 16; ++j) { const unsigned c = xb_ld(&bar[XB_XCNT(j)]); sum += c; cnt += (c > 0u) ? 1u : 0u; mine = (j == x) ? c : mine; }
        if (sum == G) break;
        __builtin_amdgcn_s_sleep(1);
        if ((++sp & 255u) == 0u) { if (xb_ld(&bar[XB_TMO])) break; if (sp > XB_SPIN_CAP) { atomicAdd(&bar[XB_TMO], 1u); break; } }
    }
    nloc = mine > 0u ? mine : 1u; nx = cnt > 0u ? cnt : 1u;
}

__device__ __forceinline__ void xcd_barrier(const XcdBarrier& b) {
    asm volatile("s_waitcnt vmcnt(0)" ::: "memory");
    __syncthreads();
    if (threadIdx.x == 0) {
        unsigned* bar = b.bar;
        __builtin_amdgcn_s_waitcnt(0);
        unsigned nloc = b.st[0], nx = b.st[1];
        if (nloc == 0u) { xcd_barrier_complete(bar, b.x, nloc, nx); b.st[0] = nloc; b.st[1] = nx; }
        const unsigned old = xb_add(&bar[XB_XSUB(b.x)], 1u);
        const unsigned gen = old / nloc;
        if (old + 1u == (gen + 1u) * nloc) {
            __builtin_amdgcn_fence(__ATOMIC_RELEASE, "agent");
            asm volatile("s_waitcnt vmcnt(0)" ::: "memory");
            const unsigned og = xb_add(&bar[XB_TOP], 1u);
            const unsigned tg = og / nx;
            if (og + 1u == (tg + 1u) * nx) xb_add(&bar[XB_TOPGEN], 1u);
            else XB_SPIN(xb_ld(&bar[XB_TOPGEN]) == tg, bar);
            __builtin_amdgcn_fence(__ATOMIC_ACQUIRE, "agent");
            xb_add(&bar[XB_XGEN(b.x)], 1u);
            asm volatile("s_waitcnt vmcnt(0)" ::: "memory");
        } else {
            XB_SPIN(xb_ld(&bar[XB_XGEN(b.x)]) == gen, bar);
            __builtin_amdgcn_fence(__ATOMIC_ACQUIRE, "agent");
            asm volatile("s_waitcnt vmcnt(0)" ::: "memory");
        }
    }
    __syncthreads();
}


namespace pg8 {
#define PG8_LAS __attribute__((address_space(3)))
typedef unsigned short bf16_t;
typedef short bf16x8 __attribute__((ext_vector_type(8)));
typedef float f32x4 __attribute__((ext_vector_type(4)));
typedef unsigned u32x4 __attribute__((ext_vector_type(4)));
constexpr int BM = 256, BK = 64, HALF = 128, HTB = HALF * BK * 2  , STAGE_BYTES = 8 * HTB, NXCD = 8, WGM = 8;

__host__ __device__ __forceinline__ int lds_byte(int r, int c) { const int st = (r >> 4) * 2 + (c >> 5), rr = r & 15, cc = c & 31, ob = rr * 64 + cc * 2; return st * 1024 + (ob ^ (((ob >> 9) & 1) << 5)); }
__host__ __device__ __forceinline__ void stage_rc(int b, int& R, int& C) { const int st = b / 1024, sb = b % 1024, swz = sb ^ (((sb >> 9) & 1) << 5); R = (st >> 1) * 16 + swz / 64; C = (st & 1) * 32 + (swz % 64) / 2; }
__host__ __device__ __forceinline__ int perm32(int rho) { const int n = rho >> 4, i = rho & 15; return 8 * (i >> 2) + 4 * n + (i & 3); }

struct Unit { int pm, pn; };
struct Gemm { const bf16_t* A; const bf16_t* Bt; int M, N, K; };

struct StaticOrder {
    int nM, nN, nwg, G, c;
    __host__ __device__ void init(int M, int N, int G_, int c_) { nM = M / BM; nN = N / BM; nwg = nM * nN; G = G_; c = c_; }
    __host__ __device__ bool next(int i, Unit& u) const {
        const long L = (long)i * G + c; if (L >= nwg) return false;
        int wgid = (int)L; { const int q = nwg / NXCD, r = nwg % NXCD, xcd = wgid % NXCD, off = wgid / NXCD; wgid = (xcd < r ? xcd * (q + 1) : r * (q + 1) + (xcd - r) * q) + off; }
        const int nig = WGM * nN, gid = wgid / nig, fm = gid * WGM, gsz = (nM - fm) < WGM ? (nM - fm) : WGM;
        u.pm = fm + ((wgid % nig) % gsz); u.pn = (wgid % nig) / gsz; return true;
    }
    __device__ __forceinline__ void a_ready(const Unit&) const {}
    __device__ __forceinline__ void done(const Unit&) const {}
};
template <class Epi, class Sched, bool STAMP = false>
__device__ __forceinline__ void gemm_phase(PG8_LAS unsigned char* lds, const Gemm g, const Sched& S, const Epi& E, unsigned long long* stamps) {
    const int tid = opaque_tid(), wid = __builtin_amdgcn_readfirstlane(tid >> 6), lane = tid & 63, wr = wid >> 2, wc = wid & 3, fr = lane & 15, fq = lane >> 4;
    const int K = g.K, nt = K / BK;
    int ts_lo = 0, ts_hi = 0, nts = 0; const unsigned long long rt_entry = STAMP ? (unsigned long long)wall_clock64() : 0ull;
#define PG8_STAMP() do { if (STAMP && wid == 0 && nts < 64) { const unsigned long long _c = (unsigned long long)clock64(); \
        ts_lo = (lane == nts) ? (int)(unsigned)_c : ts_lo; ts_hi = (lane == nts) ? (int)(unsigned)(_c >> 32) : ts_hi; ++nts; } } while (0)
    PG8_STAMP();
    unsigned voffA[2], voffB[2];
#pragma unroll
    for (int i = 0; i < 2; ++i) { int R, C; stage_rc(tid * 16 + i * 8192, R, C); const int Rb = Epi::PERM ? ((R & ~31) + perm32(R & 31)) : R;
        voffA[i] = (unsigned)(R * K + C) * 2u; voffB[i] = (unsigned)(Rb * K + C) * 2u; }
    const size_t kstep = (size_t)(BK * 2);
    const size_t hstep = (size_t)HALF * K * 2;
    const size_t tstep = 2 * hstep;
    const unsigned ldsw = (unsigned)wid * 1024u;
    const int aoff = lds_byte(wr * 64 + fr, fq * 8), boff = lds_byte(wc * 32 + fr, fq * 8);
#define PG8_SA(b, h) (((b) * 2 + (h)) * HTB)
#define PG8_SB(b, h) ((4 + (b) * 2 + (h)) * HTB)
#define PG8_STAGE(bufoff, gbase, voff) do { _Pragma("unroll") for (int _i = 0; _i < 2; ++_i) \
        __builtin_amdgcn_global_load_lds((const unsigned*)((const char*)(gbase) + (voff)[_i]), (PG8_LAS unsigned*)(lds + (bufoff) + ldsw + _i * 8192), 16, 0, 0); } while (0)
#define PG8_LDA(dst, b, h) do { _Pragma("unroll") for (int m = 0; m < 4; ++m) _Pragma("unroll") for (int k = 0; k < 2; ++k) dst[m][k] = *(const PG8_LAS bf16x8*)(lds + PG8_SA(b, h) + aoff + m * 2048 + k * 1024); } while (0)
#define PG8_LDB(dst, b, h) do { _Pragma("unroll") for (int n = 0; n < 2; ++n) _Pragma("unroll") for (int k = 0; k < 2; ++k) dst[n][k] = *(const PG8_LAS bf16x8*)(lds + PG8_SB(b, h) + boff + n * 2048 + k * 1024); } while (0)
#define PG8_MMA(ai, bj, At, Bt) do { __builtin_amdgcn_s_setprio(1); _Pragma("unroll") for (int m = 0; m < 4; ++m) _Pragma("unroll") for (int n = 0; n < 2; ++n) _Pragma("unroll") for (int k = 0; k < 2; ++k) \
        acc[ai][bj][m][n] = __builtin_amdgcn_mfma_f32_16x16x32_bf16(Bt[n][k], At[m][k], acc[ai][bj][m][n], 0, 0, 0); __builtin_amdgcn_s_setprio(0); } while (0)
#define PG8_WAIT_V(n) asm volatile("s_waitcnt vmcnt(" #n ")" ::: "memory")
#define PG8_WAIT_L(n) asm volatile("s_waitcnt lgkmcnt(" #n ")" ::: "memory")
#define PG8_BAR __builtin_amdgcn_s_barrier()
#define PG8_SCHED __builtin_amdgcn_sched_barrier(0)
    Unit cur, nxt; int ui = 0;
    if (!S.next(0, cur)) return;
    f32x4 acc[2][2][4][2];
#pragma unroll
    for (int a = 0; a < 2; ++a)
#pragma unroll
        for (int b = 0; b < 2; ++b)
#pragma unroll
            for (int m = 0; m < 4; ++m)
#pragma unroll
                for (int n = 0; n < 2; ++n) acc[a][b][m][n] = (f32x4){0.f, 0.f, 0.f, 0.f};
    bf16x8 At[4][2], B0[2][2], B1[2][2];
    const char* cA = (const char*)g.A + (size_t)cur.pm * tstep; const char* cB = (const char*)g.Bt + (size_t)cur.pn * tstep;
    S.a_ready(cur);
    PG8_STAGE(PG8_SB(0, 0), cB, voffB); PG8_STAGE(PG8_SA(0, 0), cA, voffA); PG8_STAGE(PG8_SB(0, 1), cB + hstep, voffB); PG8_STAGE(PG8_SA(0, 1), cA + hstep, voffA);
    if (wr == 1) PG8_BAR;
    PG8_WAIT_V(4); PG8_BAR;
    PG8_STAGE(PG8_SB(1, 0), cB + kstep, voffB); PG8_STAGE(PG8_SA(1, 0), cA + kstep, voffA); PG8_STAGE(PG8_SB(1, 1), cB + hstep + kstep, voffB);
    PG8_WAIT_V(6); PG8_BAR;
    PG8_STAMP();
    for (;;) {
        const bool has_next = S.next(ui + 1, nxt);
        const char* nA = has_next ? (const char*)g.A + (size_t)nxt.pm * tstep : cA; const char* nB = has_next ? (const char*)g.Bt + (size_t)nxt.pn * tstep : cB;
        for (int t = 0; t < nt; t += 2) {
            const bool last = (t == nt - 2);
            const char* a1 = cA + (size_t)(t + 1) * kstep;
            const char* a2 = last ? nA : cA + (size_t)(t + 2) * kstep; const char* b2 = last ? nB : cB + (size_t)(t + 2) * kstep;
            const char* a3 = a2 + kstep; const char* b3 = b2 + kstep;
            if (last && has_next) S.a_ready(nxt);
            PG8_LDB(B0, 0, 0); PG8_SCHED; PG8_LDA(At, 0, 0); PG8_STAGE(PG8_SA(1, 1), a1 + hstep, voffA);
            PG8_WAIT_L(8); PG8_BAR; PG8_WAIT_L(0); PG8_MMA(0, 0, At, B0); PG8_BAR; PG8_SCHED;
            PG8_LDB(B1, 0, 1); PG8_STAGE(PG8_SB(0, 0), b2, voffB);
            PG8_BAR; PG8_WAIT_L(0); PG8_MMA(0, 1, At, B1); PG8_BAR;
            PG8_LDA(At, 0, 1); PG8_STAGE(PG8_SA(0, 0), a2, voffA);
            PG8_BAR; PG8_WAIT_L(0); PG8_MMA(1, 0, At, B0); PG8_BAR; PG8_SCHED;
            PG8_STAGE(PG8_SB(0, 1), b2 + hstep, voffB);
            PG8_WAIT_V(6); PG8_BAR; PG8_MMA(1, 1, At, B1); PG8_BAR;
            PG8_LDB(B0, 1, 0); PG8_SCHED; PG8_LDA(At, 1, 0); PG8_STAGE(PG8_SA(0, 1), a2 + hstep, voffA);
            PG8_WAIT_L(8); PG8_BAR; PG8_WAIT_L(0); PG8_MMA(0, 0, At, B0); PG8_BAR; PG8_SCHED;
            PG8_LDB(B1, 1, 1); PG8_STAGE(PG8_SB(1, 0), b3, voffB);
            PG8_BAR; PG8_WAIT_L(0); PG8_MMA(0, 1, At, B1); PG8_BAR;
            PG8_LDA(At, 1, 1); PG8_STAGE(PG8_SA(1, 0), a3, voffA);
            PG8_BAR; PG8_WAIT_L(0); PG8_MMA(1, 0, At, B0); PG8_BAR; PG8_SCHED;
            PG8_STAGE(PG8_SB(1, 1), b3 + hstep, voffB);
            PG8_WAIT_V(6); PG8_BAR; PG8_MMA(1, 1, At, B1); PG8_BAR;
        }
        PG8_STAMP();
        if constexpr (!Epi::AFTER_DRAIN) { E(acc, cur, wr, wc, fr, fq); S.done(cur); }
        PG8_STAMP();
        if (!has_next) break;
#pragma unroll
        for (int a = 0; a < 2; ++a)
#pragma unroll
            for (int b = 0; b < 2; ++b)
#pragma unroll
                for (int m = 0; m < 4; ++m)
#pragma unroll
                    for (int n = 0; n < 2; ++n) acc[a][b][m][n] = (f32x4){0.f, 0.f, 0.f, 0.f};
        cur = nxt; cA = nA; cB = nB; ++ui;
    }
    PG8_WAIT_V(0);
    if (wr == 0) PG8_BAR;
    PG8_BAR;
    if constexpr (Epi::AFTER_DRAIN) { E.fused(acc, cur, wr, wc, fr, fq, lds, wid, lane); S.done(cur); }
    PG8_STAMP();
    if (STAMP && wid == 0) { stamps[lane] = lane < nts ? (((unsigned long long)(unsigned)ts_hi << 32) | (unsigned)ts_lo) : 0ull;
        if (lane == 62) stamps[62] = rt_entry; if (lane == 63) stamps[63] = (unsigned long long)wall_clock64(); }
#undef PG8_STAMP
#undef PG8_SA
#undef PG8_SB
#undef PG8_STAGE
#undef PG8_LDA
#undef PG8_LDB
#undef PG8_MMA
#undef PG8_WAIT_V
#undef PG8_WAIT_L
#undef PG8_BAR
#undef PG8_SCHED
}
}

struct EpiB16 {
  static constexpr bool PERM = true, AFTER_DRAIN = false;
  us* O; int ldc; int ACT;
  DI void operator()(const f32x4 (&acc)[2][2][4][2], const pg8::Unit& u, int wr, int wc, int fr, int fq) const {
    const int row0 = u.pm * 256 + wr * 64 + fr, col0 = u.pn * 256 + wc * 32 + 8 * fq;
#pragma unroll
    for (int ai = 0; ai < 2; ++ai)
#pragma unroll
      for (int m = 0; m < 4; ++m) {
        us* rowp = O + (size_t)(row0 + ai * 128 + m * 16) * ldc + col0;
#pragma unroll
        for (int bj = 0; bj < 2; ++bj) {
          f32x4 v0 = acc[ai][bj][m][0], v1 = acc[ai][bj][m][1];
          if (ACT == 1) {
#pragma unroll
            for (int j = 0; j < 4; ++j) { float a = fmaxf(v0[j], 0.f), b = fmaxf(v1[j], 0.f); v0[j] = a * a; v1[j] = b * b; }
          }
          u32x4 w = {cvt2(v0[0], v0[1]), cvt2(v0[2], v0[3]), cvt2(v1[0], v1[1]), cvt2(v1[2], v1[3])};
          *(u32x4*)(rowp + bj * 128) = w;
        }
      }
  }
};

struct ALoadCmp {
  const us* base;
  const float* pe;
  int r0;
  DI bf16x8 operator()(int r, int kt, int kc) const {
    int n = r + r0; n = n < 126 ? n : 126;
    bf16x8 v = *(const bf16x8*)(base + (size_t)(16 * n + kt) * LDP + kc * 8);
    const float* pp = pe + kt * 64 + kc * 8;
    bf16x8 o;
#pragma unroll
    for (int e = 0; e < 8; ++e) o[e] = (short)f2bf(bf2f((us)v[e]) + pp[e]);
    return o;
  }
};

template <int MW, class AL, class EPI>
DI void gemm_tile(const AL& al, const us* __restrict__ Bt, int ldb, int n0, int nk  , const EPI& epi, char* smem) {
  constexpr int BM = MW * 64, NW = 8 / MW, NT = 128 / NW / 16, AI = BM * 8 / 512, STG = (BM + 128) * 80;
  us(*As)[80] = (us(*)[80])smem;
  us(*Bs)[80] = (us(*)[80])(smem + BM * 80 * 2);
  const int tid = opaque_tid(), lane = tid & 63, wid = tid >> 6, wr = wid / NW, wc = wid % NW, fr = lane & 15, fq = lane >> 4;
  f32x4 acc[4][NT];
#pragma unroll
  for (int m = 0; m < 4; ++m)
#pragma unroll
    for (int n = 0; n < NT; ++n) acc[m][n] = f32x4{0.f, 0.f, 0.f, 0.f};
  bf16x8 ra0[AI], rb0[2], ra1[AI], rb1[2];
#define GT_LOAD(RA, RB, KT) do { \
    _Pragma("unroll") for (int i = 0; i < AI; ++i) { int c = tid + 512 * i, r = c >> 3, kc = c & 7; RA[i] = al(r, (KT), kc); } \
    _Pragma("unroll") for (int i = 0; i < 2; ++i) { int c = tid + 512 * i, r = c >> 3, kc = c & 7; RB[i] = *(const bf16x8*)(Bt + (size_t)(n0 + r) * ldb + (KT) * 64 + kc * 8); } } while (0)
#define GT_STORE(RA, RB, S) do { \
    _Pragma("unroll") for (int i = 0; i < AI; ++i) { int c = tid + 512 * i, r = c >> 3, kc = c & 7; *(bf16x8*)&As[(S) * (BM + 128) + r][kc * 8] = RA[i]; } \
    _Pragma("unroll") for (int i = 0; i < 2; ++i) { int c = tid + 512 * i, r = c >> 3, kc = c & 7; *(bf16x8*)&Bs[(S) * (BM + 128) + r][kc * 8] = RB[i]; } } while (0)
#define GT_COMPUTE(S) do { \
    _Pragma("unroll") for (int ks = 0; ks < 2; ++ks) { \
      bf16x8 af[4], bfr[NT]; \
      _Pragma("unroll") for (int m = 0; m < 4; ++m) af[m] = *(const bf16x8*)&As[(S) * (BM + 128) + wr * 64 + m * 16 + fr][ks * 32 + fq * 8]; \
      _Pragma("unroll") for (int n = 0; n < NT; ++n) bfr[n] = *(const bf16x8*)&Bs[(S) * (BM + 128) + wc * (NT * 16) + n * 16 + fr][ks * 32 + fq * 8]; \
      _Pragma("unroll") for (int m = 0; m < 4; ++m) _Pragma("unroll") for (int n = 0; n < NT; ++n) acc[m][n] = MFMA16(bfr[n], af[m], acc[m][n]); } } while (0)
  GT_LOAD(ra0, rb0, 0);
  GT_LOAD(ra1, rb1, 1);
  __syncthreads();
  GT_STORE(ra0, rb0, 0);
  __syncthreads();
  for (int kt = 0; kt < nk; kt += 2) {
    if (kt + 2 < nk) GT_LOAD(ra0, rb0, kt + 2);
    GT_COMPUTE(0);
    GT_STORE(ra1, rb1, 1);
    __syncthreads();
    if (kt + 3 < nk) GT_LOAD(ra1, rb1, kt + 3);
    GT_COMPUTE(1);
    if (kt + 2 < nk) GT_STORE(ra0, rb0, 0);
    __syncthreads();
  }
#undef GT_LOAD
#undef GT_STORE
#undef GT_COMPUTE
#pragma unroll
  for (int m = 0; m < 4; ++m)
#pragma unroll
    for (int n = 0; n < NT; ++n) epi(wr * 64 + m * 16 + fr, wc * (NT * 16) + n * 16 + fq * 4, acc[m][n]);
}

struct EpiGeluLds {
  us* Hs;
  DI void operator()(int r, int c, f32x4 v) const {
    float o[4];
#pragma unroll
    for (int j = 0; j < 4; ++j) {
      float xx = v[j];
      float t = tanhf(0.7978845608028654f * (xx + 0.044715f * xx * xx * xx));
      o[j] = 0.5f * xx * (1.f + t);
    }
    *(s16x4*)(Hs + r * 136 + c) = pack4(o[0], o[1], o[2], o[3]);
  }
};

DI int remap_win(int n) { return n < 1280 ? n : (n < 1304 ? n + 768 : n - 24); }

DI void transpose_wave(const float* __restrict__ src, int K, int N, us* __restrict__ dst, int kt, int nt, bool remap, int lane) {
  const int n = nt * 64 + lane;
  const bool ok = n < N;
  const float* sp = src + (size_t)(kt * 64) * N + (ok ? n : 0);
  float v[64];
#pragma unroll
  for (int k = 0; k < 64; ++k) v[k] = __builtin_nontemporal_load(sp + (size_t)k * N);
  if (ok) {
    const int nn = remap ? remap_win(n) : n;
    u32x4* dp = (u32x4*)(dst + (size_t)nn * K + kt * 64);
#pragma unroll
    for (int q = 0; q < 8; ++q) {
      u32x4 w = {cvt2(v[8 * q], v[8 * q + 1]), cvt2(v[8 * q + 2], v[8 * q + 3]), cvt2(v[8 * q + 4], v[8 * q + 5]), cvt2(v[8 * q + 6], v[8 * q + 7])};
      dp[q] = w;
    }
  }
}

DI void phase0(const Params& p, char* smem) {
  const int tid = opaque_tid(), lane = tid & 63, wid = tid >> 6;
  const int gw = blockIdx.x * 8 + wid, nw = gridDim.x * 8;
  for (int it = gw; it < 792; it += nw) {
    int i = it;
    if (i < 528) { transpose_wave(p.w_in, 1024, 2072, p.wt_in, i / 33, i % 33, true, lane); continue; }
    i -= 528;
    if (i < 128) { transpose_wave(p.w1_k, 2048, 256, p.w1t_k, i / 4, i % 4, false, lane); continue; }
    i -= 128;
    if (i < 128) { transpose_wave(p.w1_v, 2048, 256, p.w1t_v, i / 4, i % 4, false, lane); continue; }
    i -= 128;
    if (i < 4) { transpose_wave(p.w2_k, 256, 64, p.w2t_k, i, 0, false, lane); continue; }
    i -= 4;
    transpose_wave(p.w2_v, 256, 64, p.w2t_v, i, 0, false, lane);
  }
  {
    unsigned* z = (unsigned*)(p.wt_in + (size_t)2072 * 1024);
    for (int i = blockIdx.x * 512 + tid; i < 104 * 512; i += gridDim.x * 512) z[i] = 0u;
    float* kz = p.kcf;
    for (int i = blockIdx.x * 512 + tid; i < 2 * 32 * 128 * 64; i += gridDim.x * 512) kz[i] = 0.f;
  }
  for (int row = gw * 2; row < NTOK; row += nw * 2) {
    float4 v[2][4];
#pragma unroll
    for (int r = 0; r < 2; ++r)
#pragma unroll
      for (int i = 0; i < 4; ++i) { f32x4 t = __builtin_nontemporal_load(((const f32x4*)(p.x + (size_t)(row + r) * 1024)) + lane + 64 * i); v[r][i] = float4{t[0], t[1], t[2], t[3]}; }
    float4 g[4];
#pragma unroll
    for (int i = 0; i < 4; ++i) g[i] = ((const float4*)p.g_mix_pre)[lane + 64 * i];
#pragma unroll
    for (int r = 0; r < 2; ++r) {
      float ss = 0.f;
#pragma unroll
      for (int i = 0; i < 4; ++i) ss += v[r][i].x * v[r][i].x + v[r][i].y * v[r][i].y + v[r][i].z * v[r][i].z + v[r][i].w * v[r][i].w;
      ss = wave_sum(ss);
      const float rs = rsqrtf(ss * (1.f / 1024.f) + EPS);
#pragma unroll
      for (int i = 0; i < 4; ++i)
        *(s16x4*)(p.a + (size_t)(row + r) * 1024 + (lane + 64 * i) * 4) =
            pack4(v[r][i].x * rs * g[i].x, v[r][i].y * rs * g[i].y, v[r][i].z * rs * g[i].z, v[r][i].w * rs * g[i].w);
    }
  }
}

DI void attn_tile64(const us (*Ks)[80], const us (*Vt)[80], const bf16x8 (&qf)[2][2], f32x4 (&o)[4][2], float (&M)[2], float (&l)[2],
                    const float (&sl2)[2], const float (&qs)[2], const f32x4 (&idxf)[4], int key0, int tok, int fr, int fq,
                    int mode, int window, bool sel) {
  bf16x8 kf[4][2];
#pragma unroll
  for (int mt = 0; mt < 4; ++mt)
#pragma unroll
    for (int ks = 0; ks < 2; ++ks) kf[mt][ks] = *(const bf16x8*)&Ks[mt * 16 + fr][ks * 32 + fq * 8];
  bf16x8 vf[4][2];
#pragma unroll
  for (int dt = 0; dt < 4; ++dt)
#pragma unroll
    for (int s2 = 0; s2 < 2; ++s2) {
      s16x4 lo = lds_tr4(&Vt[s2 * 32 + fq * 4 + (fr >> 2)][dt * 16 + (fr & 3) * 4]);
      s16x4 hi = lds_tr4(&Vt[s2 * 32 + 16 + fq * 4 + (fr >> 2)][dt * 16 + (fr & 3) * 4]);
      vf[dt][s2] = __builtin_shufflevector(lo, hi, 0, 1, 2, 3, 4, 5, 6, 7);
    }
  const float Df = (float)(tok - key0);
  const float thr = (mode == 2) ? Df - (float)window : Df;
#pragma unroll
  for (int nt = 0; nt < 2; ++nt) {
    const bf16x8 q0 = nt ? qf[1][0] : qf[0][0];
    const bf16x8 q1 = nt ? qf[1][1] : qf[0][1];
    const float sl = nt ? sl2[1] : sl2[0];
    const float qsn = nt ? qs[1] : qs[0];
    const float Mold = nt ? M[1] : M[0];
    f32x4 s[4];
    __builtin_amdgcn_s_setprio(1);
#pragma unroll
    for (int mt = 0; mt < 4; ++mt) {
      s[mt] = f32x4{0.f, 0.f, 0.f, 0.f};
      s[mt] = MFMA16(kf[mt][0], q0, s[mt]);
      s[mt] = MFMA16(kf[mt][1], q1, s[mt]);
    }
    __builtin_amdgcn_s_setprio(0);
#pragma unroll
    for (int mt = 0; mt < 4; ++mt) s[mt] = s[mt] * qsn + idxf[mt];
    if (mode == 1) {
#pragma unroll
      for (int mt = 0; mt < 4; ++mt)
#pragma unroll
        for (int j = 0; j < 4; ++j) s[mt][j] = (idxf[mt][j] <= thr) ? s[mt][j] : NEG_INF;
    } else if (mode == 2) {
#pragma unroll
      for (int mt = 0; mt < 4; ++mt)
#pragma unroll
        for (int j = 0; j < 4; ++j) s[mt][j] = (idxf[mt][j] > thr) ? s[mt][j] : NEG_INF;
    }
    float mx = fmaxf(fmaxf(s[0][0], s[0][1]), fmaxf(s[0][2], s[0][3]));
#pragma unroll
    for (int mt = 1; mt < 4; ++mt) mx = fmaxf(fmaxf(mx, s[mt][0]), fmaxf(fmaxf(s[mt][1], s[mt][2]), s[mt][3]));
    mx = xor16_max(mx);
    mx = xor32_max(mx);
    mx = sel ? mx - Df : NEG_INF;
    const float Mnew = fmaxf(Mold, mx);
    const float Muse = (Mnew == NEG_INF) ? 0.f : Mnew;
    const float alpha = ex2(sl * (Mold - Muse));
    const float c = sel ? -sl * (Df + Muse) : NEG_INF;
    float ps = 0.f;
#pragma unroll
    for (int mt = 0; mt < 4; ++mt) {
      s[mt] = s[mt] * sl + c;
#pragma unroll
      for (int j = 0; j < 4; ++j) s[mt][j] = ex2(s[mt][j]);
    }
    {
      f32x4 t = (s[0] + s[1]) + (s[2] + s[3]);
      ps = (t[0] + t[1]) + (t[2] + t[3]);
    }
    bf16x8 pb[2];
#pragma unroll
    for (int s2 = 0; s2 < 2; ++s2) {
      s16x4 lo = pack4(s[2 * s2][0], s[2 * s2][1], s[2 * s2][2], s[2 * s2][3]);
      s16x4 hi = pack4(s[2 * s2 + 1][0], s[2 * s2 + 1][1], s[2 * s2 + 1][2], s[2 * s2 + 1][3]);
      pb[s2] = __builtin_shufflevector(lo, hi, 0, 1, 2, 3, 4, 5, 6, 7);
    }
    const bool resc = __ballot(alpha != 1.f) != 0ull;
    if (nt == 0) {
      M[0] = Mnew; l[0] = l[0] * alpha + ps;
      if (resc) {
#pragma unroll
        for (int dt = 0; dt < 4; ++dt) o[dt][0] *= alpha;
      }
      __builtin_amdgcn_s_setprio(1);
#pragma unroll
      for (int dt = 0; dt < 4; ++dt)
#pragma unroll
        for (int s2 = 0; s2 < 2; ++s2) o[dt][0] = MFMA16(vf[dt][s2], pb[s2], o[dt][0]);
      __builtin_amdgcn_s_setprio(0);
    } else {
      M[1] = Mnew; l[1] = l[1] * alpha + ps;
      if (resc) {
#pragma unroll
        for (int dt = 0; dt < 4; ++dt) o[dt][1] *= alpha;
      }
      __builtin_amdgcn_s_setprio(1);
#pragma unroll
      for (int dt = 0; dt < 4; ++dt)
#pragma unroll
        for (int s2 = 0; s2 < 2; ++s2) o[dt][1] = MFMA16(vf[dt][s2], pb[s2], o[dt][1]);
      __builtin_amdgcn_s_setprio(0);
    }
  }
}

DI void load_kv64(const us* __restrict__ projb, int key0, int kcol, int vcol, int tid, bf16x8& kr, bf16x8& vr) {
  const us* rp = projb + (size_t)(key0 + (tid >> 3)) * LDP + (tid & 7) * 8;
  kr = *(const bf16x8*)(rp + kcol);
  vr = *(const bf16x8*)(rp + vcol);
}
DI void store_kv64(us (*Ks)[80], us (*Vt)[80], int tid, const bf16x8& kr, const bf16x8& vr) {
  *(bf16x8*)&Ks[tid >> 3][(tid & 7) * 8] = kr;
  *(bf16x8*)&Vt[tid >> 3][(tid & 7) * 8] = vr;
}

DI void banded_item(const Params& p, int b, int g, int tq, int kind, char* smem) {
  us(*Ks)[80] = (us(*)[80])smem;
  us(*Vt)[80] = (us(*)[80])(smem + 2 * 64 * 80 * 2);
  const int tid = opaque_tid(), lane = tid & 63, w = tid >> 6, fr = lane & 15, fq = lane >> 4;
  const int tg = w >> 1, hp = w & 1;
  const int t0 = tq * 64, tok = t0 + 16 * tg + fr;
  const int qcol = kind ? C_QS : C_QN, kcol = (kind ? C_KSW : C_KW) + g * 64, vcol = (kind ? C_VSW : C_VW) + g * 64;
  const int window = kind ? 128 : 512;
  const us* projb = p.proj + (size_t)b * T * LDP;
  bf16x8 qf[2][2];
  f32x4 o[4][2];
  float m[2], l[2], slope2[2], qs[2];
  f32x4 idxf[4];
#pragma unroll
  for (int mt = 0; mt < 4; ++mt)
#pragma unroll
    for (int j = 0; j < 4; ++j) idxf[mt][j] = (float)(mt * 16 + fq * 4 + j);
#pragma unroll
  for (int r = 0; r < 2; ++r) {
    int hh = g * 4 + hp * 2 + r;
#pragma unroll
    for (int ks = 0; ks < 2; ++ks) qf[r][ks] = __builtin_nontemporal_load((const bf16x8*)(projb + (size_t)tok * LDP + qcol + hh * 64 + ks * 32 + fq * 8));
    float sl = kind ? exp2f(-(float)(hh + 1)) : exp2f(-0.5f * (float)(2 * hh + 1));
    slope2[r] = sl * LOG2E;
    qs[r] = SC2 / slope2[r];
    if (kind) { m[r] = p.sinks[hh] * LOG2E / slope2[r]; l[r] = (fq == 0) ? 1.f : 0.f; }
    else { m[r] = NEG_INF; l[r] = 0.f; }
#pragma unroll
    for (int dt = 0; dt < 4; ++dt) o[dt][r] = f32x4{0.f, 0.f, 0.f, 0.f};
  }
  int kt0 = t0 - window; if (kt0 < 0) kt0 = 0; kt0 >>= 6;
  {
    bf16x8 kr, vr;
    load_kv64(projb, tq * 64, kcol, vcol, tid, kr, vr);
    __syncthreads();
    store_kv64(Ks, Vt, tid, kr, vr);
    __syncthreads();
    int cur = 0;
    for (int kt = tq; kt >= kt0; --kt) {
      const bool more = kt > kt0;
      if (more) load_kv64(projb, (kt - 1) * 64, kcol, vcol, tid, kr, vr);
      const int mode = (kt == tq) ? 1 : ((64 * (tq - kt) + 63 >= window) ? 2 : 0);
      attn_tile64(Ks + cur * 64, Vt + cur * 64, qf, o, m, l, slope2, qs, idxf, kt * 64, tok, fr, fq, mode, window, true);
      if (more) store_kv64(Ks + (cur ^ 1) * 64, Vt + (cur ^ 1) * 64, tid, kr, vr);
      __syncthreads();
      cur ^= 1;
    }
  }
  const size_t rowg = (size_t)b * T + tok;
#pragma unroll
  for (int r = 0; r < 2; ++r) {
    float lt = l[r]; lt = xor16_sum(lt); lt = xor32_sum(lt);
    float inv = lt > 0.f ? 1.f / lt : 0.f;
    int hh = g * 4 + hp * 2 + r;
    if (!kind) inv *= p.gates[rowg * 24 + hh * 3 + 2];
    us* dst = p.attn + rowg * 1024 + (kind ? 512 : 0) + hh * 64 + fq * 4;
#pragma unroll
    for (int dt = 0; dt < 4; ++dt) *(s16x4*)(dst + dt * 16) = pack4(o[dt][r][0] * inv, o[dt][r][1] * inv, o[dt][r][2] * inv, o[dt][r][3] * inv);
  }
}

DI void compress_item(const Params& p, int item, char* smem) {
  const int mh = item & 1, nh = (item >> 1) & 1, g = (item >> 2) & 1, b = (item >> 3) & 15, kv = item >> 7;
  const us* base = p.proj + (size_t)b * T * LDP + (kv ? C_VC : C_KC) + g * 64;
  ALoadCmp al{base, kv ? p.pe_v : p.pe_k, mh * 64};
  const us* w1t = kv ? p.w1t_v : p.w1t_k;
  const us* w2t = kv ? p.w2t_v : p.w2t_k;
  float* dst = (kv ? p.vcf : p.kcf) + (size_t)(b * 2 + g) * 128 * 64 + (size_t)mh * 64 * 64;
  us* Hs = (us*)smem;
  us* Ws = (us*)(smem + 64 * 136 * 2);
  const int tid = opaque_tid(), lane = tid & 63, w = tid >> 6, fr = lane & 15, fq = lane >> 4;
  EpiGeluLds epi{Hs};
  gemm_tile<1>(al, w1t, 2048, nh * 128, 32, epi, smem);
#pragma unroll
  for (int i = 0; i < 2; ++i) {
    int c = tid + 512 * i, r = c >> 4, ch = c & 15;
    *(bf16x8*)(Ws + r * 136 + ch * 8) = *(const bf16x8*)(w2t + (size_t)r * 256 + nh * 128 + ch * 8);
  }
  __syncthreads();
  const int mrow = (w & 3) * 16, n0 = (w >> 2) * 2;
  f32x4 acc[2];
#pragma unroll
  for (int n = 0; n < 2; ++n) acc[n] = f32x4{0.f, 0.f, 0.f, 0.f};
#pragma unroll
  for (int ks = 0; ks < 4; ++ks) {
    bf16x8 af = *(const bf16x8*)(Hs + (mrow + fr) * 136 + ks * 32 + fq * 8);
#pragma unroll
    for (int n = 0; n < 2; ++n) {
      bf16x8 bfr = *(const bf16x8*)(Ws + ((n0 + n) * 16 + fr) * 136 + ks * 32 + fq * 8);
      acc[n] = MFMA16(bfr, af, acc[n]);
    }
  }
#pragma unroll
  for (int n = 0; n < 2; ++n) {
    float* d = dst + (size_t)(mrow + fr) * 64 + (n0 + n) * 16 + fq * 4;
#pragma unroll
    for (int j = 0; j < 4; ++j) atomicAdd(d + j, acc[n][j]);
  }
  __syncthreads();
}

DI void cmp_probs(const us* KcS, const bf16x8 (&qfn)[2], float slope2, int tok, int fr, int fq, int npair, f32x4 (&s)[8]) {
  float mx = NEG_INF;
#pragma unroll
  for (int pr = 0; pr < 4; ++pr) {
    if (pr < npair) {
#pragma unroll
      for (int h = 0; h < 2; ++h) {
        const int mt = pr * 2 + h;
        s[mt] = f32x4{0.f, 0.f, 0.f, 0.f};
#pragma unroll
        for (int ks = 0; ks < 2; ++ks) {
          bf16x8 kf = *(const bf16x8*)(KcS + (mt * 16 + fr) * 80 + ks * 32 + fq * 8);
          s[mt] = MFMA16(kf, qfn[ks], s[mt]);
        }
      }
#pragma unroll
      for (int h = 0; h < 2; ++h) {
        const int mt = pr * 2 + h;
#pragma unroll
        for (int j = 0; j < 4; ++j) {
          int n = mt * 16 + fq * 4 + j;
          int dist = tok - (16 * n + 31);
          float v = dist >= 0 ? (s[mt][j] * SC2 - slope2 * (float)dist) : NEG_INF;
          s[mt][j] = v;
          mx = fmaxf(mx, v);
        }
      }
    }
  }
  mx = xor16_max(mx);
  mx = xor32_max(mx);
  float muse = (mx == NEG_INF) ? 0.f : mx;
  float ps = 0.f;
#pragma unroll
  for (int pr = 0; pr < 4; ++pr) {
    if (pr < npair) {
#pragma unroll
      for (int h = 0; h < 2; ++h)
#pragma unroll
        for (int j = 0; j < 4; ++j) { float pv = ex2(s[pr * 2 + h][j] - muse); s[pr * 2 + h][j] = pv; ps += pv; }
    } else {
      s[pr * 2] = f32x4{0.f, 0.f, 0.f, 0.f}; s[pr * 2 + 1] = f32x4{0.f, 0.f, 0.f, 0.f};
    }
  }
  ps = xor16_sum(ps);
  ps = xor32_sum(ps);
  float inv = ps > 0.f ? 1.f / ps : 0.f;
#pragma unroll
  for (int mt = 0; mt < 8; ++mt) s[mt] *= inv;
}

DI void nsa_item(const Params& p, int b, int g, int tq, char* smem) {
  us* KcS = (us*)smem;
  us* VcT = (us*)(smem + 20480);
  us(*Ks)[80] = (us(*)[80])(smem + 40960);
  us(*Vt)[80] = (us(*)[80])(smem + 61440);
  float* impS = (float*)(smem + 81920);
  float* impL = (float*)(smem + 98816);
  unsigned* unionS = (unsigned*)(smem + 115712);
  u32x4* ocS = (u32x4*)smem;
  const int tid = opaque_tid(), lane = tid & 63, w = tid >> 6, fr = lane & 15, fq = lane >> 4;
  const int tg = w >> 1, hp = w & 1;
  const int t0 = tq * 64, tok = t0 + 16 * tg + fr;
  const us* projb = p.proj + (size_t)b * T * LDP;
  const float* kcf = p.kcf + (size_t)(b * 2 + g) * 128 * 64;
  const float* vcf = p.vcf + (size_t)(b * 2 + g) * 128 * 64;
  const size_t rowg = (size_t)b * T + tok;
  int npair = ((tq * 4 + 2) >> 5) + 1; if (npair > 4) npair = 4;
  const int nrows = npair * 32;
  __syncthreads();
#pragma unroll
  for (int i = 0; i < 2; ++i) {
    int c = tid + 512 * i, r = c >> 3, ch = c & 7;
    if (r >= nrows) continue;
    const float4* s4 = (const float4*)(kcf + r * 64 + ch * 8);
    float4 a0 = s4[0], a1 = s4[1];
    s16x4 lo = pack4(a0.x, a0.y, a0.z, a0.w), hi = pack4(a1.x, a1.y, a1.z, a1.w);
    *(bf16x8*)(KcS + r * 80 + ch * 8) = __builtin_shufflevector(lo, hi, 0, 1, 2, 3, 4, 5, 6, 7);
  }
#pragma unroll
  for (int i = 0; i < 2; ++i) {
    int c = tid + 512 * i, r = c >> 3, ch = c & 7;
    if (r >= nrows) continue;
    const float4* s4 = (const float4*)(vcf + r * 64 + ch * 8);
    float4 a0 = s4[0], a1 = s4[1];
    s16x4 lo = pack4(a0.x, a0.y, a0.z, a0.w), hi = pack4(a1.x, a1.y, a1.z, a1.w);
    *(bf16x8*)(VcT + r * 80 + ch * 8) = __builtin_shufflevector(lo, hi, 0, 1, 2, 3, 4, 5, 6, 7);
  }
  if (tid == 0) *unionS = 0u;
  bf16x8 qf[2][2];
  float slope2[2];
#pragma unroll
  for (int r = 0; r < 2; ++r) {
    int hh = g * 4 + hp * 2 + r;
#pragma unroll
    for (int ks = 0; ks < 2; ++ks) qf[r][ks] = __builtin_nontemporal_load((const bf16x8*)(projb + (size_t)tok * LDP + C_QN + hh * 64 + ks * 32 + fq * 8));
    slope2[r] = exp2f(-0.5f * (float)(2 * hh + 1)) * LOG2E;
  }
  __syncthreads();
  u32x4 ocp[4];
  {
    float accA[8], accL[8];
#pragma unroll
    for (int mt = 0; mt < 8; ++mt) { accA[mt] = 0.f; accL[mt] = 0.f; }
#pragma unroll 1
    for (int nt = 0; nt < 2; ++nt) {
      bf16x8 qn[2];
      qn[0] = nt ? qf[1][0] : qf[0][0];
      qn[1] = nt ? qf[1][1] : qf[0][1];
      f32x4 s[8];
      int frz = fr, fqz = fq, tokz = tok;
      asm volatile("" : "+v"(frz), "+v"(fqz), "+v"(tokz));
      cmp_probs(KcS, qn, nt ? slope2[1] : slope2[0], tokz, frz, fqz, npair, s);
#pragma unroll
      for (int mt = 0; mt < 8; ++mt) {
        accA[mt] += (s[mt][0] + s[mt][1]) + (s[mt][2] + s[mt][3]);
        accL[mt] += s[mt][3];
      }
      const float g0 = p.gates[rowg * 24 + (g * 4 + hp * 2 + nt) * 3 + 0];
      f32x4 tmp[4];
#pragma unroll
      for (int dt = 0; dt < 4; ++dt) tmp[dt] = f32x4{0.f, 0.f, 0.f, 0.f};
#pragma unroll
      for (int s2 = 0; s2 < 4; ++s2) {
        if (s2 >= npair) continue;
        s16x4 lo = pack4(s[2 * s2][0], s[2 * s2][1], s[2 * s2][2], s[2 * s2][3]);
        s16x4 hi = pack4(s[2 * s2 + 1][0], s[2 * s2 + 1][1], s[2 * s2 + 1][2], s[2 * s2 + 1][3]);
        bf16x8 pb = __builtin_shufflevector(lo, hi, 0, 1, 2, 3, 4, 5, 6, 7);
#pragma unroll
        for (int dt = 0; dt < 4; ++dt) {
          s16x4 vlo = lds_tr4(VcT + (s2 * 32 + fqz * 4 + (frz >> 2)) * 80 + dt * 16 + (frz & 3) * 4);
          s16x4 vhi = lds_tr4(VcT + (s2 * 32 + 16 + fqz * 4 + (frz >> 2)) * 80 + dt * 16 + (frz & 3) * 4);
          bf16x8 vf = __builtin_shufflevector(vlo, vhi, 0, 1, 2, 3, 4, 5, 6, 7);
          tmp[dt] = MFMA16(vf, pb, tmp[dt]);
        }
      }
      u32x4 lo4 = {cvt2(tmp[0][0] * g0, tmp[0][1] * g0), cvt2(tmp[0][2] * g0, tmp[0][3] * g0), cvt2(tmp[1][0] * g0, tmp[1][1] * g0), cvt2(tmp[1][2] * g0, tmp[1][3] * g0)};
      u32x4 hi4 = {cvt2(tmp[2][0] * g0, tmp[2][1] * g0), cvt2(tmp[2][2] * g0, tmp[2][3] * g0), cvt2(tmp[3][0] * g0, tmp[3][1] * g0), cvt2(tmp[3][2] * g0, tmp[3][3] * g0)};
      if (nt == 0) { ocp[0] = lo4; ocp[1] = hi4; } else { ocp[2] = lo4; ocp[3] = hi4; }
    }
    float* ia = impS + (hp * 64 + tg * 16 + fr) * 33;
    float* il = impL + (hp * 64 + tg * 16 + fr) * 33;
#pragma unroll
    for (int mt = 0; mt < 8; ++mt) {
      const int j = mt * 4 + fq;
      ia[j] = accA[mt];
      if (j < 31) il[j + 1] = accL[mt]; else il[0] = 0.f;
    }
  }
  __syncthreads();
#pragma unroll
  for (int q = 0; q < 4; ++q) ocS[q * 512 + tid] = ocp[q];
  unsigned sel;
  {
    const unsigned valid = (tq == 31) ? 0xffffffffu : ((1u << (tq + 1)) - 1u);
    unsigned forced = 1u | (1u << tq);
    if (tq > 0) forced |= 1u << (tq - 1);
    sel = forced & valid;
    int cnt = __popc(sel);
    float cand[8];
    {
      const float* a0 = impS + (tg * 16 + fr) * 33, *a1 = impS + (64 + tg * 16 + fr) * 33;
      const float* l0 = impL + (tg * 16 + fr) * 33, *l1 = impL + (64 + tg * 16 + fr) * 33;
#pragma unroll
      for (int mt = 0; mt < 8; ++mt) { const int j = mt * 4 + fq; cand[mt] = (a0[j] + a1[j]) + (l0[j] + l1[j]); }
    }
    for (int round = 0; round < 8; ++round) {
      if (cnt < 8) {
        const unsigned open = valid & ~sel;
        float bv = -1.f; int bj = 64;
#pragma unroll
        for (int mt = 0; mt < 8; ++mt) {
          const int j = mt * 4 + fq;
          if (((open >> j) & 1u) && cand[mt] > bv) { bv = cand[mt]; bj = j; }
        }
#pragma unroll
        for (int step = 0; step < 2; ++step) {
          const unsigned uv = __float_as_uint(bv), uj = (unsigned)bj;
          float v0, v1; int j0, j1;
          if (step == 0) {
            auto rv = __builtin_amdgcn_permlane16_swap(uv, uv, false, false); auto rj = __builtin_amdgcn_permlane16_swap(uj, uj, false, false);
            v0 = __uint_as_float(rv[0]); v1 = __uint_as_float(rv[1]); j0 = (int)rj[0]; j1 = (int)rj[1];
          } else {
            auto rv = __builtin_amdgcn_permlane32_swap(uv, uv, false, false); auto rj = __builtin_amdgcn_permlane32_swap(uj, uj, false, false);
            v0 = __uint_as_float(rv[0]); v1 = __uint_as_float(rv[1]); j0 = (int)rj[0]; j1 = (int)rj[1];
          }
          const bool take1 = (v1 > v0) || (v1 == v0 && j1 < j0);
          bv = take1 ? v1 : v0; bj = take1 ? j1 : j0;
        }
        if (bj < 32) { sel |= 1u << bj; cnt++; }
      }
    }
  }
  atomicOr(unionS, sel);
  f32x4 o[4][2];
  float m[2], l[2], qs[2];
  f32x4 idxf[4];
#pragma unroll
  for (int mt = 0; mt < 4; ++mt)
#pragma unroll
    for (int j = 0; j < 4; ++j) idxf[mt][j] = (float)(mt * 16 + fq * 4 + j);
#pragma unroll
  for (int r = 0; r < 2; ++r) {
    qs[r] = SC2 / slope2[r];
    m[r] = NEG_INF; l[r] = 0.f;
#pragma unroll
    for (int dt = 0; dt < 4; ++dt) o[dt][r] = f32x4{0.f, 0.f, 0.f, 0.f};
  }
  {
    const int kcol = C_KW + g * 64, vcol = C_VW + g * 64;
    int kt0 = t0 - 512; if (kt0 < 0) kt0 = 0; kt0 >>= 6;
    bf16x8 kr, vr;
    load_kv64(projb, tq * 64, kcol, vcol, tid, kr, vr);
    store_kv64(Ks, Vt, tid, kr, vr);
    __syncthreads();
    int cur = 0;
    for (int kt = tq; kt >= kt0; --kt) {
      const bool more = kt > kt0;
      if (more) load_kv64(projb, (kt - 1) * 64, kcol, vcol, tid, kr, vr);
      const int mode = (kt == tq) ? 1 : ((64 * (tq - kt) + 63 >= 512) ? 2 : 0);
      attn_tile64(Ks + cur * 64, Vt + cur * 64, qf, o, m, l, slope2, qs, idxf, kt * 64, tok, fr, fq, mode, 512, true);
      if (more) store_kv64(Ks + (cur ^ 1) * 64, Vt + (cur ^ 1) * 64, tid, kr, vr);
      __syncthreads();
      cur ^= 1;
    }
#pragma unroll
    for (int r = 0; r < 2; ++r) {
      float lt = l[r]; lt = xor16_sum(lt); lt = xor32_sum(lt);
      const float sc = (lt > 0.f ? 1.f / lt : 0.f) * p.gates[rowg * 24 + (g * 4 + hp * 2 + r) * 3 + 2];
#pragma unroll
      for (int half = 0; half < 2; ++half) {
        u32x4 oc = ocS[(r * 2 + half) * 512 + tid];
#pragma unroll
        for (int d2 = 0; d2 < 2; ++d2) {
          const int dt = half * 2 + d2;
          const unsigned c01 = oc[d2 * 2], c23 = oc[d2 * 2 + 1];
          oc[d2 * 2] = cvt2(o[dt][r][0] * sc + bf2f((us)(c01 & 0xffffu)), o[dt][r][1] * sc + bf2f((us)(c01 >> 16)));
          oc[d2 * 2 + 1] = cvt2(o[dt][r][2] * sc + bf2f((us)(c23 & 0xffffu)), o[dt][r][3] * sc + bf2f((us)(c23 >> 16)));
        }
        ocS[(r * 2 + half) * 512 + tid] = oc;
      }
      m[r] = NEG_INF; l[r] = 0.f;
#pragma unroll
      for (int dt = 0; dt < 4; ++dt) o[dt][r] = f32x4{0.f, 0.f, 0.f, 0.f};
    }
  }
  const unsigned uni = *unionS;
  {
    unsigned rem = uni;
    int j = 31 - __clz(rem); rem &= ~(1u << j);
    bf16x8 kr, vr;
    load_kv64(projb, j * 64, C_KS + g * 64, C_VS + g * 64, tid, kr, vr);
    store_kv64(Ks, Vt, tid, kr, vr);
    __syncthreads();
    int cur = 0;
    while (true) {
      const bool more = rem != 0u;
      const int jn = more ? (31 - __clz(rem)) : 0;
      if (more) rem &= ~(1u << jn);
      if (more) load_kv64(projb, jn * 64, C_KS + g * 64, C_VS + g * 64, tid, kr, vr);
      {
        const bool selj = ((sel >> j) & 1u) != 0;
        if (__ballot(selj) != 0ull)
          attn_tile64(Ks + cur * 64, Vt + cur * 64, qf, o, m, l, slope2, qs, idxf, j * 64, tok, fr, fq, (j == tq) ? 1 : 0, 0, selj);
      }
      if (more) store_kv64(Ks + (cur ^ 1) * 64, Vt + (cur ^ 1) * 64, tid, kr, vr);
      __syncthreads();
      if (!more) break;
      cur ^= 1; j = jn;
    }
  }
#pragma unroll
  for (int r = 0; r < 2; ++r) {
    float lt = l[r]; lt = xor16_sum(lt); lt = xor32_sum(lt);
    const float sc = (lt > 0.f ? 1.f / lt : 0.f) * p.gates[rowg * 24 + (g * 4 + hp * 2 + r) * 3 + 1];
    us* dst = p.attn + rowg * 1024 + (g * 4 + hp * 2 + r) * 64 + fq * 4;
#pragma unroll
    for (int half = 0; half < 2; ++half) {
      const u32x4 oc = ocS[(r * 2 + half) * 512 + tid];
#pragma unroll
      for (int d2 = 0; d2 < 2; ++d2) {
        const int dt = half * 2 + d2;
        const unsigned c01 = oc[d2 * 2], c23 = oc[d2 * 2 + 1];
        *(s16x4*)(dst + dt * 16) = pack4(o[dt][r][0] * sc + bf2f((us)(c01 & 0xffffu)), o[dt][r][1] * sc + bf2f((us)(c01 >> 16)),
                                         o[dt][r][2] * sc + bf2f((us)(c23 & 0xffffu)), o[dt][r][3] * sc + bf2f((us)(c23 >> 16)));
      }
    }
  }
}

DI void phase5(const Params& p) {
  const int tid = opaque_tid(), lane = tid & 63, wid = tid >> 6;
  const us* mix = p.a; us* mbuf = p.attn;
  for (int row = (blockIdx.x * 8 + wid) * 2; row < NTOK; row += gridDim.x * 16) {
    s16x4 mt[2][4]; float4 xv[2][4];
#pragma unroll
    for (int r = 0; r < 2; ++r)
#pragma unroll
      for (int i = 0; i < 4; ++i) {
        mt[r][i] = __builtin_nontemporal_load((const s16x4*)(mix + (size_t)(row + r) * 1024 + (lane + 64 * i) * 4));
        { f32x4 t = __builtin_nontemporal_load(((const f32x4*)(p.x + (size_t)(row + r) * 1024)) + lane + 64 * i); xv[r][i] = float4{t[0], t[1], t[2], t[3]}; }
      }
#pragma unroll
    for (int r = 0; r < 2; ++r) {
      float mv[4][4]; float ss = 0.f;
#pragma unroll
      for (int i = 0; i < 4; ++i)
#pragma unroll
        for (int j = 0; j < 4; ++j) { mv[i][j] = bf2f((us)mt[r][i][j]); ss += mv[i][j] * mv[i][j]; }
      ss = wave_sum(ss);
      const float r1 = rsqrtf(ss * (1.f / 1024.f) + EPS);
      float hv[4][4]; float ss2 = 0.f;
#pragma unroll
      for (int i = 0; i < 4; ++i) {
        float4 g = ((const float4*)p.g_mix_post)[lane + 64 * i];
        hv[i][0] = xv[r][i].x + mv[i][0] * r1 * g.x; hv[i][1] = xv[r][i].y + mv[i][1] * r1 * g.y;
        hv[i][2] = xv[r][i].z + mv[i][2] * r1 * g.z; hv[i][3] = xv[r][i].w + mv[i][3] * r1 * g.w;
#pragma unroll
        for (int j = 0; j < 4; ++j) ss2 += hv[i][j] * hv[i][j];
      }
      ss2 = wave_sum(ss2);
      const float r2 = rsqrtf(ss2 * (1.f / 1024.f) + EPS);
#pragma unroll
      for (int i = 0; i < 4; ++i) {
        float4 g = ((const float4*)p.g_mlp_pre)[lane + 64 * i];
        *(s16x4*)(mbuf + (size_t)(row + r) * 1024 + (lane + 64 * i) * 4) = pack4(hv[i][0] * r2 * g.x, hv[i][1] * r2 * g.y, hv[i][2] * r2 * g.z, hv[i][3] * r2 * g.w);
      }
    }
  }
}
DI void phase8(const Params& p) {
  const int tid = opaque_tid(), lane = tid & 63, wid = tid >> 6;
  const us* mix = p.a; const us* dn = p.attn;
  for (int row = (blockIdx.x * 8 + wid) * 2; row < NTOK; row += gridDim.x * 16) {
    s16x4 mt[2][4], dt[2][4]; float4 xv[2][4];
#pragma unroll
    for (int r = 0; r < 2; ++r)
#pragma unroll
      for (int i = 0; i < 4; ++i) {
        mt[r][i] = __builtin_nontemporal_load((const s16x4*)(mix + (size_t)(row + r) * 1024 + (lane + 64 * i) * 4));
        dt[r][i] = __builtin_nontemporal_load((const s16x4*)(dn + (size_t)(row + r) * 1024 + (lane + 64 * i) * 4));
        { f32x4 t = __builtin_nontemporal_load(((const f32x4*)(p.x + (size_t)(row + r) * 1024)) + lane + 64 * i); xv[r][i] = float4{t[0], t[1], t[2], t[3]}; }
      }
#pragma unroll
    for (int r = 0; r < 2; ++r) {
      float ss = 0.f, sd = 0.f;
#pragma unroll
      for (int i = 0; i < 4; ++i)
#pragma unroll
        for (int j = 0; j < 4; ++j) { float a = bf2f((us)mt[r][i][j]), b = bf2f((us)dt[r][i][j]); ss += a * a; sd += b * b; }
      ss = wave_sum(ss); sd = wave_sum(sd);
      const float r1 = rsqrtf(ss * (1.f / 1024.f) + EPS), r3 = rsqrtf(sd * (1.f / 1024.f) + EPS);
#pragma unroll
      for (int i = 0; i < 4; ++i) {
        float4 g1 = ((const float4*)p.g_mix_post)[lane + 64 * i];
        float4 g4 = ((const float4*)p.g_mlp_post)[lane + 64 * i];
        float4 h = xv[r][i];
        h.x = (h.x + bf2f((us)mt[r][i][0]) * r1 * g1.x) + bf2f((us)dt[r][i][0]) * r3 * g4.x;
        h.y = (h.y + bf2f((us)mt[r][i][1]) * r1 * g1.y) + bf2f((us)dt[r][i][1]) * r3 * g4.y;
        h.z = (h.z + bf2f((us)mt[r][i][2]) * r1 * g1.z) + bf2f((us)dt[r][i][2]) * r3 * g4.z;
        h.w = (h.w + bf2f((us)mt[r][i][3]) * r1 * g1.w) + bf2f((us)dt[r][i][3]) * r3 * g4.w;
        __builtin_nontemporal_store(f32x4{h.x, h.y, h.z, h.w}, ((f32x4*)(p.out + (size_t)(row + r) * 1024)) + lane + 64 * i);
      }
    }
  }
}

DI void late_weights_item(const Params& p, int item) {
  const int tid = opaque_tid(), lane = tid & 63, wid = tid >> 6;
  int i = item * 8 + wid;
  if (i < 256) { transpose_wave(p.w_out, 1024, 1024, p.wt_out, i / 16, i % 16, false, lane); return; }
  i -= 256;
  if (i < 1024) { transpose_wave(p.w_up, 1024, 4096, p.wt_up, i / 64, i % 64, false, lane); return; }
  i -= 1024;
  transpose_wave(p.w_down, 4096, 1024, p.wt_dn, i / 16, i % 16, false, lane);
}

DI void gates_rows(const Params& p, int row0, char* smem) {
  const int tid = opaque_tid(), lane = tid & 63, w = tid >> 6, fr = lane & 15, fq = lane >> 4;
  us* Bs = (us*)smem;
  __syncthreads();
#pragma unroll
  for (int i = 0; i < 8; ++i) {
    int c = tid + 512 * i, r = c >> 7, ch = c & 127;
    *(bf16x8*)(Bs + r * 1032 + ch * 8) = *(const bf16x8*)(p.wt_in + (size_t)(2048 + r) * 1024 + ch * 8);
  }
  __syncthreads();
  const us* ap = p.a + (size_t)(row0 + w * 16 + fr) * 1024 + fq * 8;
  const us* bp = Bs + fr * 1032 + fq * 8;
  f32x4 acc[2] = {f32x4{0.f, 0.f, 0.f, 0.f}, f32x4{0.f, 0.f, 0.f, 0.f}};
#pragma unroll 8
  for (int ks = 0; ks < 32; ++ks) {
    bf16x8 af = *(const bf16x8*)(ap + ks * 32);
    bf16x8 b0 = *(const bf16x8*)(bp + ks * 32);
    bf16x8 b1 = *(const bf16x8*)(bp + 16 * 1032 + ks * 32);
    acc[0] = MFMA16(b0, af, acc[0]);
    acc[1] = MFMA16(b1, af, acc[1]);
  }
  float* gp = p.gates + (size_t)(row0 + w * 16 + fr) * 24;
#pragma unroll
  for (int n = 0; n < 2; ++n) {
    if (n == 0 || fq < 2) {
      f32x4 o;
#pragma unroll
      for (int j = 0; j < 4; ++j) o[j] = 1.f / (1.f + __expf(-acc[n][j]));
      *(f32x4*)(gp + n * 16 + fq * 4) = o;
    }
  }
}

constexpr int LDS_BYTES = 131072 + 16;
__global__ void __launch_bounds__(512, 2) mega(Params p) {
  extern __shared__ __attribute__((aligned(16))) char smem[];
  cg::grid_group grid = cg::this_grid();
  if (p.phase_hi > NPH) grid.sync();
  volatile LAS unsigned* xst = (volatile LAS unsigned*)(smem + 131072);
  if (threadIdx.x < 4) xst[threadIdx.x] = 0u;
  __syncthreads();
  const XcdBarrier xb = xcd_barrier_post(p.bar, xst);
  for (int ph = p.phase_lo; ph < p.phase_hi; ++ph) {
    const bool is_gemm = (ph == 1) | (ph == 4) | (ph == 6) | (ph == 7);
    if (is_gemm) {
      const us* A = (ph == 1) ? p.a : (ph == 7 ? p.u : p.attn);
      const us* Bt = (ph == 1) ? p.wt_in : (ph == 4 ? p.wt_out : (ph == 6 ? p.wt_up : p.wt_dn));
      us* O = (ph == 1) ? p.proj : (ph == 6 ? p.u : (ph == 4 ? p.a : p.attn));
      const int N = (ph == 1) ? 2048 : (ph == 6 ? 4096 : 1024);
      const int K = (ph == 7) ? 4096 : 1024;
      const bool gates_first = (ph == 1) && (((blockIdx.x >> 3) & 1) != 0);
      if (gates_first) {
        for (int r0 = blockIdx.x * 128; r0 < NTOK; r0 += gridDim.x * 128) gates_rows(p, r0, smem);
        __syncthreads();
      }
      pg8::StaticOrder S; S.init(NTOK, N, (int)gridDim.x, (int)blockIdx.x);
      pg8::Gemm g{A, Bt, NTOK, N, K};
      EpiB16 E{O, N, ph == 6 ? 1 : 0};
      pg8::gemm_phase<EpiB16, pg8::StaticOrder, false>((PG8_LAS unsigned char*)smem, g, S, E, nullptr);
      if (ph == 1 && !gates_first)
        for (int r0 = blockIdx.x * 128; r0 < NTOK; r0 += gridDim.x * 128) gates_rows(p, r0, smem);
    } else if (ph == 0) {
      phase0(p, smem);
    } else if (ph == 2 || ph == 3) {
      volatile LAS int* qslot = (volatile LAS int*)(smem + 131072 + 8);
      unsigned* ctr = p.bar + 3584 + (ph - 2) * 64;
      const int nitems = (ph == 2) ? 256 : (1024 + 1024 + 288);
      int it = blockIdx.x;
      while (it < nitems) {
        int nx = 0;
        if (threadIdx.x == 0) nx = (int)gridDim.x + (int)atomicAdd(ctr, 1u);
        if (ph == 2) {
          compress_item(p, it, smem);
        } else if (it < 1024) {
          int g = 1 - (it >> 9), r9 = it & 511;
          nsa_item(p, r9 & 15, g, 31 - (r9 >> 4), smem);
        } else if (it < 1024 + 288) {
          late_weights_item(p, it - 1024);
        } else {
          int i = it - (1024 + 288);
          int tq = 31 - (i >> 5), rem = i & 31;
          banded_item(p, rem >> 1, rem & 1, tq, 1, smem);
        }
        if (threadIdx.x == 0) *qslot = nx;
        __syncthreads();
        it = *qslot;
        __syncthreads();
      }
    } else if (ph == 5) {
      phase5(p);
    } else {
      phase8(p);
    }
    if (ph + 1 < p.phase_hi) xcd_barrier(xb);
  }
}

extern "C" void kernel_launch(void* const* d_in, const int* in_sizes, int n_in, void* d_out, int out_size, void* d_ws, size_t ws_size,
                              hipStream_t stream) {
  static int grid_blocks = 0;
  if (!grid_blocks) {
    int dev = 0, cus = 0, per_cu = 0;
    (void)hipGetDevice(&dev);
    (void)hipDeviceGetAttribute(&cus, hipDeviceAttributeMultiprocessorCount, dev);
    (void)hipFuncSetAttribute((const void*)mega, hipFuncAttributeMaxDynamicSharedMemorySize, LDS_BYTES);
    (void)hipOccupancyMaxActiveBlocksPerMultiprocessor(&per_cu, (const void*)mega, 512, LDS_BYTES);
    if (per_cu < 1) per_cu = 1;
    if (per_cu > 1) per_cu = 1;
    grid_blocks = cus * per_cu;
  }
  Params p{};
  const float* const* in = (const float* const*)d_in;
  p.x = in[0]; p.g_mix_pre = in[1]; p.w_in = in[2]; p.pe_k = in[3]; p.w1_k = in[4]; p.w2_k = in[5]; p.pe_v = in[6]; p.w1_v = in[7];
  p.w2_v = in[8]; p.sinks = in[9]; p.w_out = in[10]; p.g_mix_post = in[11]; p.g_mlp_pre = in[12]; p.w_up = in[13]; p.w_down = in[14];
  p.g_mlp_post = in[15];
  p.out = (float*)d_out;
  char* ws = (char*)d_ws;
  const size_t MB = 1024 * 1024;
  p.a = (us*)(ws);
  p.attn = (us*)(ws + 64 * MB);
  p.proj = (us*)(ws + 128 * MB);
  p.u = (us*)(ws + 128 * MB);
  char* w = ws + 384 * MB;
  p.wt_in = (us*)w;  w += (size_t)2176 * 1024 * 2;
  p.wt_out = (us*)w; w += (size_t)1024 * 1024 * 2;
  p.wt_up = (us*)w;  w += (size_t)4096 * 1024 * 2;
  p.wt_dn = (us*)w;  w += (size_t)4096 * 1024 * 2;
  p.w1t_k = (us*)w;  w += (size_t)256 * 2048 * 2;
  p.w1t_v = (us*)w;  w += (size_t)256 * 2048 * 2;
  p.w2t_k = (us*)w;  w += (size_t)64 * 256 * 2;
  p.w2t_v = (us*)w;  w += (size_t)64 * 256 * 2;
  p.gates = (float*)w; w += (size_t)NTOK * 24 * 4;
  p.kcf = (float*)w; w += (size_t)32 * 128 * 64 * 4;
  p.vcf = (float*)w; w += (size_t)32 * 128 * 64 * 4;
  p.bar = (unsigned*)w; w += 16384;
  (void)hipMemsetAsync(p.bar, 0, 16384, stream);
  p.phase_lo = 0; p.phase_hi = NPH;
  void* args[] = {&p};
  hipError_t e = hipLaunchCooperativeKernel((const void*)mega, dim3(grid_blocks), dim3(512), args, LDS_BYTES, stream);
  if (e != hipSuccess) fprintf(stderr, "cooperative launch failed: %s (grid %d)\n", hipGetErrorString(e), grid_blocks);
}
```
